# Optimizing an MI355X kernel written in HIP

```python
import jax
import jax.numpy as jnp
from jax import lax
import numpy as np


D_MODEL = 1024
BATCH = 4
SEQ = 8192
DEPTH = 1

GRID_W = 64
MEM_LEN = 256
NA_HEADS = 8
NA_HEAD_DIM = 64
NA_WIN_ROWS = 8
NA_WIN_COLS = 16
FT_GROUPS = 4
FT_GROUP_DIM = 128
MEM_HEADS = 4
MEM_HEAD_DIM = 128
NA_WIDTH = NA_HEADS * NA_HEAD_DIM
FT_WIDTH = FT_GROUPS * FT_GROUP_DIM
MEM_WIDTH = MEM_HEADS * MEM_HEAD_DIM
MIX_WIDTH = NA_WIDTH + FT_WIDTH + MEM_WIDTH
IN_WIDTH = 3 * NA_WIDTH + FT_WIDTH + MEM_WIDTH
N_EXPERTS = 32
TOP_K = 4
D_EXPERT = D_MODEL
SWIGLU_LIMIT = 7.0
SWIGLU_ALPHA = 1.702
MOE_BLOCK = 512
EPS = 1e-6

kernel_name = 'hymba_natten_fnet_memory_moe_encoder'


def rmsnorm(x, g):
    xf = x.astype(jnp.float32)
    y = xf * lax.rsqrt(jnp.mean(xf * xf, axis=-1, keepdims=True) + EPS)
    return (y * g.astype(jnp.float32)).astype(x.dtype)


def neighbourhood_attention(q, k, v, rel_bias):
    b, s = q.shape[0], q.shape[1]
    rows = s // GRID_W
    win_r = min(NA_WIN_ROWS, rows)

    def to_grid(t):
        return t.reshape(b, rows, GRID_W, NA_HEADS, NA_HEAD_DIM).transpose(0, 3, 1, 2, 4)

    qg, kg, vg = to_grid(q), to_grid(k), to_grid(v)
    r = np.arange(rows)
    row_start = np.clip(r - win_r // 2, 0, rows - win_r)
    row_idx = row_start[:, None] + np.arange(win_r)[None, :]
    k_rows = kg[:, :, row_idx]
    v_rows = vg[:, :, row_idx]
    c = np.arange(GRID_W)
    col_start = np.clip(c - NA_WIN_COLS // 2, 0, GRID_W - NA_WIN_COLS)
    col_in = (c[None, :] >= col_start[:, None]) & (c[None, :] < col_start[:, None] + NA_WIN_COLS)
    dr = row_idx - r[:, None]
    dc = np.clip(c[None, :] - c[:, None], -(NA_WIN_COLS - 1), NA_WIN_COLS - 1)
    bias = rel_bias[:, dr[:, None, :, None] + (NA_WIN_ROWS - 1), dc[None, :, None, :] + (NA_WIN_COLS - 1)]
    scores = jnp.einsum('bhrqd,bhrjcd->bhrqjc', qg, k_rows).astype(jnp.float32) * (NA_HEAD_DIM ** -0.5)
    scores = jnp.where(col_in[None, None, None, :, None, :], scores + bias[None].astype(jnp.float32), -jnp.inf)
    p = jax.nn.softmax(scores.reshape(b, NA_HEADS, rows, GRID_W, win_r * GRID_W), axis=-1).astype(v.dtype)
    o = jnp.einsum('bhrqk,bhrkd->bhrqd', p, v_rows.reshape(b, NA_HEADS, rows, win_r * GRID_W, NA_HEAD_DIM))
    return o.transpose(0, 2, 3, 1, 4).reshape(b, s, NA_WIDTH)


def fourier_mix(u):
    b, s = u.shape[0], u.shape[1]
    ug = u.astype(jnp.float32).reshape(b, s, FT_GROUPS, FT_GROUP_DIM)
    f = jnp.fft.fft2(ug, axes=(1, 3), norm='ortho')
    return jnp.real(f).reshape(b, s, FT_WIDTH).astype(u.dtype)


def memory_attention(q, mem_n, w_mem_kv):
    b, s = q.shape[0], q.shape[1]
    kv = mem_n @ w_mem_kv
    k = kv[..., :MEM_WIDTH].reshape(b, -1, MEM_HEADS, MEM_HEAD_DIM)
    v = kv[..., MEM_WIDTH:].reshape(b, -1, MEM_HEADS, MEM_HEAD_DIM)
    qh = q.reshape(b, s, MEM_HEADS, MEM_HEAD_DIM)
    scores = jnp.einsum('bshd,bmhd->bhsm', qh, k).astype(jnp.float32) * (MEM_HEAD_DIM ** -0.5)
    p = jax.nn.softmax(scores, axis=-1).astype(v.dtype)
    return jnp.einsum('bhsm,bmhd->bshd', p, v).reshape(b, s, MEM_WIDTH)


def routed_ffn(h, router_w, router_b, w_gu, b_gu, w_down, b_down):
    b, s, d = h.shape
    t = b * s
    hf = h.reshape(t, d)
    logits = (hf @ router_w + router_b).astype(jnp.float32)
    top_val, top_idx = lax.top_k(logits, TOP_K)
    gates = jax.nn.softmax(top_val, axis=-1).astype(h.dtype)
    n_assign = t * TOP_K
    e_flat = top_idx.reshape(-1)
    tok_flat = jnp.repeat(jnp.arange(t, dtype=jnp.int32), TOP_K)
    order = jnp.argsort(e_flat, stable=True)
    e_sorted = e_flat[order]
    tok_sorted = tok_flat[order]
    gate_sorted = gates.reshape(-1)[order]
    counts = jnp.bincount(e_flat, length=N_EXPERTS)
    padded = (counts + MOE_BLOCK - 1) // MOE_BLOCK * MOE_BLOCK
    padded_end = jnp.cumsum(padded)
    group_start = jnp.cumsum(counts) - counts
    dest = (padded_end - padded)[e_sorted] + jnp.arange(n_assign, dtype=jnp.int32) - group_start[e_sorted]
    n_blocks = -(-n_assign // MOE_BLOCK) + N_EXPERTS
    n_slots = n_blocks * MOE_BLOCK
    slot_tok = jnp.zeros((n_slots,), jnp.int32).at[dest].set(tok_sorted)
    slot_gate = jnp.zeros((n_slots,), h.dtype).at[dest].set(gate_sorted)
    block_expert = jnp.minimum(
        jnp.searchsorted(padded_end, jnp.arange(n_blocks, dtype=jnp.int32) * MOE_BLOCK, side='right'),
        N_EXPERTS - 1)

    def expert_block(args):
        tok_b, gate_b, e = args
        xb = hf[tok_b]
        gu = xb @ w_gu[e] + b_gu[e]
        x_glu = jnp.minimum(gu[:, :D_EXPERT], SWIGLU_LIMIT)
        x_lin = jnp.clip(gu[:, D_EXPERT:], -SWIGLU_LIMIT, SWIGLU_LIMIT)
        act = x_glu * jax.nn.sigmoid(SWIGLU_ALPHA * x_glu) * (x_lin + 1.0)
        y = act @ w_down[e] + b_down[e]
        return y * gate_b[:, None]

    y = lax.map(expert_block, (slot_tok.reshape(n_blocks, MOE_BLOCK), slot_gate.reshape(n_blocks, MOE_BLOCK), block_expert))
    out = jax.ops.segment_sum(y.reshape(n_slots, d), slot_tok, num_segments=t)
    return out.reshape(b, s, d)


def setup_inputs(seed: int = 0) -> dict:
    key = jax.random.key(seed)
    ks = jax.random.split(key, 18)

    def nrm(k, shape, scale):
        return jax.random.normal(k, shape, jnp.float32) * scale

    return {
        'x': nrm(ks[0], (BATCH, SEQ, D_MODEL), 1.0),
        'mem': nrm(ks[1], (BATCH, MEM_LEN, D_MODEL), 1.0),
        'g_mix': 1.0 + nrm(ks[2], (DEPTH, D_MODEL), 0.02),
        'g_mem': 1.0 + nrm(ks[3], (DEPTH, D_MODEL), 0.02),
        'w_in': nrm(ks[4], (DEPTH, D_MODEL, IN_WIDTH), D_MODEL ** -0.5),
        'w_mem_kv': nrm(ks[5], (DEPTH, D_MODEL, 2 * MEM_WIDTH), D_MODEL ** -0.5),
        'na_rel_bias': nrm(ks[6], (DEPTH, NA_HEADS, 2 * NA_WIN_ROWS - 1, 2 * NA_WIN_COLS - 1), 0.1),
        'g_grp': 1.0 + nrm(ks[7], (DEPTH, MIX_WIDTH), 0.02),
        'w_out': nrm(ks[8], (DEPTH, MIX_WIDTH, D_MODEL), MIX_WIDTH ** -0.5),
        'g_ffn': 1.0 + nrm(ks[9], (DEPTH, D_MODEL), 0.02),
        'router_w': nrm(ks[10], (DEPTH, D_MODEL, N_EXPERTS), D_MODEL ** -0.5),
        'router_b': nrm(ks[11], (DEPTH, N_EXPERTS), 0.01),
        'w_gu': nrm(ks[12], (DEPTH, N_EXPERTS, D_MODEL, 2 * D_EXPERT), D_MODEL ** -0.5),
        'b_gu': nrm(ks[13], (DEPTH, N_EXPERTS, 2 * D_EXPERT), 0.01),
        'w_down': nrm(ks[14], (DEPTH, N_EXPERTS, D_EXPERT, D_MODEL), D_EXPERT ** -0.5),
        'b_down': nrm(ks[15], (DEPTH, N_EXPERTS, D_MODEL), 0.01),
        'g_final': 1.0 + nrm(ks[16], (D_MODEL,), 0.02),
    }


def reference(x, mem, g_mix, g_mem, w_in, w_mem_kv, na_rel_bias, g_grp, w_out, g_ffn,
              router_w, router_b, w_gu, b_gu, w_down, b_down, g_final):
    splits = [NA_WIDTH, 2 * NA_WIDTH, 3 * NA_WIDTH, 3 * NA_WIDTH + FT_WIDTH]
    for l in range(DEPTH):
        h = rmsnorm(x, g_mix[l])
        proj = h @ w_in[l]
        q_na, k_na, v_na, u_ft, q_mem = jnp.split(proj, splits, axis=-1)
        mem_n = rmsnorm(mem, g_mem[l])
        y_na = neighbourhood_attention(q_na, k_na, v_na, na_rel_bias[l])
        y_ft = fourier_mix(u_ft)
        y_mem = memory_attention(q_mem, mem_n, w_mem_kv[l])
        g = g_grp[l]
        y = jnp.concatenate([
            rmsnorm(y_na, g[:NA_WIDTH]),
            rmsnorm(y_ft, g[NA_WIDTH:NA_WIDTH + FT_WIDTH]),
            rmsnorm(y_mem, g[NA_WIDTH + FT_WIDTH:]),
        ], axis=-1)
        x = x + y @ w_out[l]
        h2 = rmsnorm(x, g_ffn[l])
        x = x + routed_ffn(h2, router_w[l], router_b[l], w_gu[l], b_gu[l], w_down[l], b_down[l])
    return rmsnorm(x, g_final)
```

```cpp
#include <hip/hip_runtime.h>
#include <hip/hip_runtime.h>
#include <cstdio>
#include <cstdint>

#define LAS __attribute__((address_space(3)))

#define XB_TMO      128
#define XB_XCNT(j)  (256  + 64 * (j))
#define XB_XSUB(j)  (1280 + 64 * (j))
#define XB_XGEN(j)  (2304 + 64 * (j))
#define XB_TOP      3328
#define XB_TOPGEN   3392
#define XCD_BAR_WORDS 3456
#define XB_SPIN_CAP (1u << 22)

__device__ __forceinline__ unsigned xb_ld(unsigned* p)              { return __hip_atomic_load(p, __ATOMIC_RELAXED, __HIP_MEMORY_SCOPE_AGENT); }
__device__ __forceinline__ unsigned xb_add(unsigned* p, unsigned v) { return __hip_atomic_fetch_add(p, v, __ATOMIC_RELAXED, __HIP_MEMORY_SCOPE_AGENT); }
__device__ __forceinline__ unsigned xb_xcc_id() { return (unsigned)__builtin_amdgcn_s_getreg((3 << 11) | 20) & 0xFu; }
#define XB_SPIN(cond, bar) do { unsigned _sp = 0; while (cond) { __builtin_amdgcn_s_sleep(1); \
    if ((++_sp & 255u) == 0u) { if (xb_ld(&(bar)[XB_TMO])) break; if (_sp > XB_SPIN_CAP) { atomicAdd(&(bar)[XB_TMO], 1u); break; } } } } while (0)

struct XcdBarrier { unsigned* bar; unsigned x; volatile LAS unsigned* st; };

__device__ __forceinline__ XcdBarrier xcd_barrier_post(unsigned* bar, volatile LAS unsigned* st) {
    XcdBarrier b; b.bar = bar; b.x = xb_xcc_id(); b.st = st;
    if (threadIdx.x == 0) (void)xb_add(&bar[XB_XCNT(b.x)], 1u);
    return b;
}
__device__ __forceinline__ void xcd_barrier_complete(unsigned* bar, unsigned x, unsigned& nloc, unsigned& nx) {
    const unsigned G = gridDim.x * gridDim.y * gridDim.z;
    unsigned sum, cnt, mine, sp = 0u;
    for (;;) {
        sum = 0u; cnt = 0u; mine = 0u;
#pragma unroll
        for (unsigned j = 0; j < 16; ++j) { const unsigned c = xb_ld(&bar[XB_XCNT(j)]); sum += c; cnt += (c > 0u) ? 1u : 0u; mine = (j == x) ? c : mine; }
        if (sum == G) break;
        __builtin_amdgcn_s_sleep(1);
        if ((++sp & 255u) == 0u) { if (xb_ld(&bar[XB_TMO])) break; if (sp > XB_SPIN_CAP) { atomicAdd(&bar[XB_TMO], 1u); break; } }
    }
    nloc = mine > 0u ? mine : 1u; nx = cnt > 0u ? cnt : 1u;
}
__device__ __forceinline__ void xcd_barrier(const XcdBarrier& b) {
    asm volatile("s_waitcnt vmcnt(0)" ::: "memory");
    __syncthreads();
    if (threadIdx.x == 0) {
        unsigned* bar = b.bar;
        __builtin_amdgcn_s_waitcnt(0);
        unsigned nloc = b.st[0], nx = b.st[1];
        if (nloc == 0u) { xcd_barrier_complete(bar, b.x, nloc, nx); b.st[0] = nloc; b.st[1] = nx; }
        const unsigned old = xb_add(&bar[XB_XSUB(b.x)], 1u);
        const unsigned gen = old / nloc;
        if (old + 1u == (gen + 1u) * nloc) {
            __builtin_amdgcn_fence(__ATOMIC_RELEASE, "agent");
            asm volatile("s_waitcnt vmcnt(0)" ::: "memory");
            const unsigned og = xb_add(&bar[XB_TOP], 1u);
            const unsigned tg = og / nx;
            if (og + 1u == (tg + 1u) * nx) xb_add(&bar[XB_TOPGEN], 1u);
            else XB_SPIN(xb_ld(&bar[XB_TOPGEN]) == tg, bar);
            __builtin_amdgcn_fence(__ATOMIC_ACQUIRE, "agent");
            xb_add(&bar[XB_XGEN(b.x)], 1u);
            asm volatile("s_waitcnt vmcnt(0)" ::: "memory");
        } else {
            XB_SPIN(xb_ld(&bar[XB_XGEN(b.x)]) == gen, bar);
            __builtin_amdgcn_fence(__ATOMIC_ACQUIRE, "agent");
            asm volatile("s_waitcnt vmcnt(0)" ::: "memory");
        }
    }
    __syncthreads();
}

constexpr int T = 32768, D = 1024, SEQ = 8192, INW = 2560, MIXW = 1536, NE = 32;
constexpr int NTH = 512;
constexpr int LDS_BYTES = 163840;
constexpr int MAXSLOT = 131072 + 32 * 256;
constexpr int LDS_CTRL = 151552;
constexpr int LDS_XBW = LDS_CTRL;
constexpr int LDS_SBASE = LDS_CTRL + 64;
constexpr int LDS_TILEE = LDS_CTRL + 512;
constexpr int LDS_IDX = LDS_CTRL + 4096;

constexpr size_t MiB = 1u << 20;
constexpr size_t WS_CTL = 0, CTL_ZERO_BYTES = 32 * 1024;
constexpr int CW_CNT = 0, CW_BAR = 4096;
constexpr size_t WS_TAB128 = 1 * MiB, WS_TAB64 = WS_TAB128 + 4096, WS_TAB8192 = WS_TAB128 + 8192;
constexpr size_t WS_MEMN = 2 * MiB;
constexpr size_t WS_WKV = 4 * MiB;
constexpr size_t WS_KMEM = 6 * MiB, WS_VMEM = 7 * MiB;
constexpr size_t WS_TOKE = 10 * MiB, WS_TOKG = WS_TOKE + 512 * 1024, WS_TOKPOS = 11 * MiB, WS_TOKSLOT = WS_TOKPOS + 512 * 1024;
constexpr size_t WS_SLOTTOK = 12 * MiB, WS_SLOTGATE = 13 * MiB;
constexpr size_t WS_TABC = 1 * MiB + 128 * 1024, WS_TABS = WS_TABC + 32 * 1024, WS_TABSN = WS_TABS + 32 * 1024, WS_TAB2 = WS_TABSN + 32 * 1024;
constexpr size_t WS_RWH = 1 * MiB + 256 * 1024, WS_RWL = WS_RWH + 64 * 1024;
constexpr size_t WS_PSS = 18 * MiB;
constexpr size_t WS_PSS2 = 20 * MiB;
constexpr size_t WS_IDENT = 16 * MiB;
constexpr size_t WS_BBASE = 14 * MiB, WS_RSBUF = 14 * MiB + 64 * 1024, WS_SLOTRS = 15 * MiB;
constexpr size_t WS_WIN = 32 * MiB;
constexpr size_t WS_WOUT = 40 * MiB;
constexpr size_t WS_WGU = 48 * MiB;
constexpr size_t WS_WD = 176 * MiB;
constexpr size_t WS_H8 = 208 * MiB;
constexpr size_t WS_HB = 240 * MiB;
constexpr size_t WS_PROJ = 304 * MiB;
constexpr size_t WS_V = 432 * MiB;
constexpr size_t WS_MID = 496 * MiB;
constexpr size_t WS_YCAT = 560 * MiB;
constexpr size_t WS_Y = 576 * MiB;
constexpr size_t WS_YCATN = 656 * MiB;
constexpr size_t WS_END = 848 * MiB;
constexpr int PW = 2560;

struct Params {
    const float *x, *mem, *g_mix, *g_mem, *w_in, *w_mem_kv, *rel_bias, *g_grp, *w_out, *g_ffn, *router_w, *router_b, *w_gu, *b_gu, *w_down, *b_down, *g_final;
    float* out; unsigned char* ws;
};

typedef unsigned short bf16;
typedef float ntf4 __attribute__((ext_vector_type(4)));
typedef unsigned ntu4 __attribute__((ext_vector_type(4)));
typedef unsigned ntu2 __attribute__((ext_vector_type(2)));
__device__ __forceinline__ float4 ld_nt_f4(const float* p) { const ntf4 t = __builtin_nontemporal_load((const ntf4*)p); return make_float4(t[0], t[1], t[2], t[3]); }
__device__ __forceinline__ unsigned f2bf(float f) { unsigned u = __builtin_bit_cast(unsigned, f); return (u + 0x7fffu + ((u >> 16) & 1u)) >> 16; }
__device__ __forceinline__ unsigned pk2(float lo, float hi) { return f2bf(lo) | (f2bf(hi) << 16); }
typedef float f32x2_t __attribute__((ext_vector_type(2)));
typedef __bf16 bf16x2_t __attribute__((ext_vector_type(2)));
__device__ __forceinline__ unsigned pkbf(float a, float b) { f32x2_t v = {a, b}; bf16x2_t r = __builtin_convertvector(v, bf16x2_t); return __builtin_bit_cast(unsigned, r); }
__device__ __forceinline__ float bf2f(bf16 b) { return __builtin_bit_cast(float, ((unsigned)b) << 16); }
__device__ __forceinline__ float wave_sum(float v) {
#pragma unroll
    for (int o = 1; o < 64; o <<= 1) v += __shfl_xor(v, o);
    return v;
}
__device__ __forceinline__ float wave_max(float v) {
#pragma unroll
    for (int o = 1; o < 64; o <<= 1) v = fmaxf(v, __shfl_xor(v, o));
    return v;
}

namespace pg8 {
#define PG8_LAS __attribute__((address_space(3)))
typedef unsigned short bf16_t;
typedef short bf16x8 __attribute__((ext_vector_type(8)));
typedef float f32x4 __attribute__((ext_vector_type(4)));
typedef unsigned u32x4 __attribute__((ext_vector_type(4)));
typedef unsigned u32x2 __attribute__((ext_vector_type(2)));
constexpr int BM = 256, BK = 64, HALF = 128, HTB = HALF * BK * 2, STAGE_BYTES = 8 * HTB;

__host__ __device__ __forceinline__ int lds_byte(int r, int c) { const int st = (r >> 4) * 2 + (c >> 5), rr = r & 15, cc = c & 31, ob = rr * 64 + cc * 2; return st * 1024 + (ob ^ (((ob >> 9) & 1) << 5)); }
__host__ __device__ __forceinline__ void stage_rc(int b, int& R, int& C) { const int st = b / 1024, sb = b % 1024, swz = sb ^ (((sb >> 9) & 1) << 5); R = (st >> 1) * 16 + swz / 64; C = (st & 1) * 32 + (swz % 64) / 2; }
__host__ __device__ __forceinline__ int perm32(int rho) { const int n = rho >> 4, i = rho & 15; return 8 * (i >> 2) + 4 * n + (i & 3); }

struct Unit { int pm, pn, e, pl; };
struct Gemm { const bf16_t* A; const bf16_t* Bt; int K; };

typedef int i32x4 __attribute__((ext_vector_type(4)));
typedef int i32x8 __attribute__((ext_vector_type(8)));
__device__ __forceinline__ i32x8 cat8(const bf16x8 lo, const bf16x8 hi) { return __builtin_shufflevector(__builtin_bit_cast(i32x4, lo), __builtin_bit_cast(i32x4, hi), 0, 1, 2, 3, 4, 5, 6, 7); }
__device__ __forceinline__ unsigned cvt_pk_bf16(float lo, float hi) { unsigned r; asm volatile("v_cvt_pk_bf16_f32 %0, %1, %2" : "=v"(r) : "v"(lo), "v"(hi)); return r; }

struct GroupOrder {
    int ntm, nN, nunits, Q, xcd, j, W, RG, rev; const PG8_LAS int* tile_e; const int* rowidx;
    __device__ void init(int ntm_, int nN_, int RG_, int G, int c, const PG8_LAS int* te, const int* ri) {
        ntm = ntm_; nN = nN_; RG = RG_; nunits = ntm * nN; tile_e = te; rowidx = ri; rev = 0;
        if (G % 8 == 0) { xcd = c % 8; j = c / 8; W = G / 8; Q = (nunits + 7) / 8; } else { xcd = 0; j = c; W = G; Q = nunits; }
    }
    __device__ __forceinline__ bool next(int i, Unit& u) const {
        const int ii = i * W + j; if (ii >= Q) return false;
        int idx = xcd * Q + ii; if (idx >= nunits) return false;
        if (rev) { const int hi = (xcd * Q + Q < nunits ? xcd * Q + Q : nunits) - 1; idx = hi - ii; }
        const int nig = RG * nN, gid = idx / nig, fm = gid * RG, gsz = (ntm - fm) < RG ? (ntm - fm) : RG, rem = idx - gid * nig;
        u.pm = fm + rem % gsz; u.pl = rem / gsz; u.e = tile_e ? tile_e[u.pm] : 0; u.pn = u.e * nN + u.pl; return true;
    }
    __device__ __forceinline__ void a_ready(const Unit&) const {}
    __device__ __forceinline__ void done(const Unit&) const {}
};

__device__ __forceinline__ unsigned pk_fp8x4(float a, float b, float c, float d) { int r = 0; r = __builtin_amdgcn_cvt_pk_fp8_f32(a, b, r, false); r = __builtin_amdgcn_cvt_pk_fp8_f32(c, d, r, true); return (unsigned)r; }
struct NoSide { static constexpr bool ON = false; };
struct SideGu { static constexpr bool ON = true; const float* W; unsigned char* WT; int first, count, bid; };
constexpr int SIDE_LDS = 131072, SIDE_WPITCH = 1040, SIDE_BUF = 8 * SIDE_WPITCH;
template <bool F8> struct FragSel { typedef bf16x8 type; };
template <> struct FragSel<true> { typedef i32x8 type; };
template <class Epi, class Sched, bool GATHER, bool FP8 = false, class Side = NoSide>
__device__ __forceinline__ void gemm_phase(PG8_LAS unsigned char* lds, PG8_LAS int* idxbuf, const Gemm g, const Sched& S, const Epi& E, const Side SD = Side()) {
    int tid = threadIdx.x; asm volatile("" : "+v"(tid));
    const int wid = __builtin_amdgcn_readfirstlane(tid >> 6), lane = tid & 63, wr = wid >> 2, wc = wid & 3, fr = lane & 15, fq = lane >> 4;
    const int K = g.K, nt = K / BK;
    unsigned voffB[2];
#pragma unroll
    for (int i = 0; i < 2; ++i) { int R, C; stage_rc(tid * 16 + i * 8192, R, C); const int Rb = Epi::PERM ? ((R & ~31) + perm32(R & 31)) : R;
        voffB[i] = (unsigned)(Rb * K + C) * 2u; }
    const size_t kstep = (size_t)(BK * 2);
    const size_t hstep = (size_t)HALF * K * 2;
    const size_t tstep = 2 * hstep;
    const unsigned ldsw = (unsigned)wid * 1024u;
    const int aoff = lds_byte(wr * 64 + fr, fq * 8), boff = lds_byte(wc * 32 + fr, fq * 8);
    const PG8_LAS unsigned char* ldsA = lds + aoff; const PG8_LAS unsigned char* ldsB = lds + 4 * HTB + boff;
    asm volatile("" : "+v"(ldsA), "+v"(ldsB));
#define PG8_SA(b, h) (((b) * 2 + (h)) * HTB)
#define PG8_SB(b, h) ((4 + (b) * 2 + (h)) * HTB)
#define PG8_STAGE(bufoff, gbase, voff) do { _Pragma("unroll") for (int _i = 0; _i < 2; ++_i) \
        __builtin_amdgcn_global_load_lds((const unsigned*)((const char*)(gbase) + (voff)[_i]), (PG8_LAS unsigned*)(lds + (bufoff) + ldsw + _i * 8192), 16, 0, 0); } while (0)
#define PG8_LDF(dst, base, off) do { if constexpr (FP8) { const i32x4 _lo = *(const PG8_LAS i32x4*)((base) + (off)), _hi = *(const PG8_LAS i32x4*)((base) + (off) + 1024); dst[0] = __builtin_shufflevector(_lo, _hi, 0, 1, 2, 3, 4, 5, 6, 7); } \
        else { _Pragma("unroll") for (int k = 0; k < 2; ++k) dst[k] = *(const PG8_LAS FragT*)((base) + (off) + k * 1024); } } while (0)
#define PG8_LDA(dst, b, h) do { _Pragma("unroll") for (int m = 0; m < 4; ++m) PG8_LDF(dst[m], ldsA, ((b) * 2 + (h)) * HTB + m * 2048); } while (0)
#define PG8_LDB(dst, b, h) do { _Pragma("unroll") for (int n = 0; n < 2; ++n) PG8_LDF(dst[n], ldsB, ((b) * 2 + (h)) * HTB + n * 2048); } while (0)
#define PG8_MMA(ai, bj, At, Bt) do { __builtin_amdgcn_s_setprio(1); _Pragma("unroll") for (int m = 0; m < 4; ++m) _Pragma("unroll") for (int n = 0; n < 2; ++n) { \
        if constexpr (FP8) acc[ai][bj][m][n] = __builtin_amdgcn_mfma_scale_f32_16x16x128_f8f6f4(Bt[n][0], At[m][0], acc[ai][bj][m][n], 0, 0, 0, 0, 0, 0); \
        else { _Pragma("unroll") for (int k = 0; k < 2; ++k) acc[ai][bj][m][n] = __builtin_amdgcn_mfma_f32_16x16x32_bf16(Bt[n][k], At[m][k], acc[ai][bj][m][n], 0, 0, 0); } } \
        __builtin_amdgcn_s_setprio(0); } while (0)
#define PG8_WAIT_VKR(rx) do { if (rx) asm volatile("s_waitcnt vmcnt(%0)" :: "n"((Side::ON ? 10 : 8) + Epi::NST) : "memory"); else PG8_WAIT_VK; } while (0)
#define PG8_WAIT_VK do { if constexpr (Side::ON) asm volatile("s_waitcnt vmcnt(10)" ::: "memory"); else asm volatile("s_waitcnt vmcnt(8)" ::: "memory"); } while (0)
#define PG8_SIDE_J(j) const int _J = SD.first + ((j) < SD.count ? (j) : SD.count - 1);
#define PG8_SIDE_DMA(j, par) do { if constexpr (Side::ON) { PG8_SIDE_J(j) \
        __builtin_amdgcn_global_load_lds((const unsigned*)(sd_src0 + ((size_t)_J << 21) + sd_lsrc), (PG8_LAS unsigned*)(lds + SIDE_LDS + (par) * SIDE_BUF + wid * SIDE_WPITCH), 16, 0, 2); } } while (0)
#define PG8_SIDE_RD(par) do { if constexpr (Side::ON) { const PG8_LAS unsigned char* _b = lds + SIDE_LDS + (par) * SIDE_BUF + sd_lrd; _Pragma("unroll") for (int _q = 0; _q < 4; ++_q) sdv[_q] = *(const PG8_LAS float*)(_b + _q * 128); } } while (0)
#define PG8_SIDE_ST(j) do { if constexpr (Side::ON) { PG8_SIDE_J(j) PG8_WAIT_L(0); \
        *(unsigned*)(sd_dst0 + ((size_t)(_J >> 2) << 21) + (_J & 3) * 256 + sd_ldst) = pk_fp8x4(sdv[0] * 32.0f, sdv[1] * 32.0f, sdv[2] * 32.0f, sdv[3] * 32.0f); } } while (0)
#define PG8_WAIT_V(n) asm volatile("s_waitcnt vmcnt(" #n ")" ::: "memory")
#define PG8_WAIT_L(n) asm volatile("s_waitcnt lgkmcnt(" #n ")" ::: "memory")
#define PG8_BAR __builtin_amdgcn_s_barrier()
#define PG8_SCHED __builtin_amdgcn_sched_barrier(0)
#define PG8_SETV(v, par) do { _Pragma("unroll") for (int _i = 0; _i < 2; ++_i) { int _R, _C; stage_rc(tid * 16 + _i * 8192, _R, _C); _Pragma("unroll") for (int _h = 0; _h < 2; ++_h) { \
        if constexpr (GATHER) v[_h][_i] = (unsigned)idxbuf[(par) * 256 + _h * 128 + _R] * (unsigned)(K * 2) + (unsigned)_C * 2u; \
        else v[_h][_i] = (unsigned)((_h * 128 + _R) * K) * 2u + (unsigned)_C * 2u; } } } while (0)
#define PG8_AUXDMA(u, par) do { if constexpr (Epi::AUX) { PG8_LAS float* _ax = (PG8_LAS float*)(idxbuf + 512) + (par) * 512; \
        if (wid >= 4) __builtin_amdgcn_global_load_lds((const unsigned*)(E.rowsrc(u) + (wid - 4) * 64 + lane), (PG8_LAS unsigned*)(_ax + (wid - 4) * 64), 4, 0, 0); \
        else __builtin_amdgcn_global_load_lds((const unsigned*)(E.colsrc(u, wid) + lane), (PG8_LAS unsigned*)(_ax + 256 + wid * 64), 4, 0, 0); } } while (0)
#define PG8_IDXDMA(u, par) do { if constexpr (GATHER) { if (wid < 4) \
        __builtin_amdgcn_global_load_lds((const unsigned*)(S.rowidx + (size_t)(u).pm * 256 + wid * 64 + lane), (PG8_LAS unsigned*)(idxbuf + (par) * 256 + wid * 64), 4, 0, 0); } } while (0)
    Unit cur, nxt; int ui = 0;
    if (!S.next(0, cur)) return;
    int sj = 0; float sdv[4];
    const unsigned sd_lsrc = (unsigned)((lane >> 3) * 8192 + (lane & 7) * 16), sd_lrd = (unsigned)(((lane & 15) >> 1) * SIDE_WPITCH + (lane & 1) * 512 + (4 * wid + (lane >> 4)) * 4), sd_ldst = (unsigned)((lane >> 4) * 1024 + 4 * (lane & 15));
    const char* sd_src0 = nullptr; unsigned char* sd_dst0 = nullptr;
    if constexpr (Side::ON) { const int nb = SD.bid & 63, kq = SD.bid >> 6;
        sd_src0 = (const char*)SD.W + (size_t)((kq * 64 + wid * 8) * 8192 + nb * 128);
        sd_dst0 = SD.WT + (size_t)((((nb >> 2) & 7) * 256 + (nb >> 5) * 128 + (nb & 3) * 32 + 4 * wid) * 1024 + kq * 64); }
    PG8_SIDE_DMA(0, 0);
    f32x4 acc[2][2][4][2];
#pragma unroll
    for (int a = 0; a < 2; ++a)
#pragma unroll
        for (int b = 0; b < 2; ++b)
#pragma unroll
            for (int m = 0; m < 4; ++m)
#pragma unroll
                for (int n = 0; n < 2; ++n) acc[a][b][m][n] = (f32x4){0.f, 0.f, 0.f, 0.f};
    typedef typename FragSel<FP8>::type FragT; constexpr int KF = FP8 ? 1 : 2;
    FragT At[4][KF], B0[2][KF], B1[2][KF];
    const char* cA = GATHER ? (const char*)g.A : (const char*)g.A + (size_t)cur.pm * tstep; const char* cB = (const char*)g.Bt + (size_t)cur.pn * tstep;
    unsigned cv[2][2], nv[2][2];
    if constexpr (GATHER) { PG8_IDXDMA(cur, 0); PG8_WAIT_V(0); PG8_BAR; }
    PG8_SETV(cv, 0);
    S.a_ready(cur);
    PG8_STAGE(PG8_SB(0, 0), cB, voffB); PG8_STAGE(PG8_SB(0, 1), cB + hstep, voffB); PG8_STAGE(PG8_SA(0, 0), cA, cv[0]); PG8_STAGE(PG8_SA(0, 1), cA, cv[1]);
    if (wr == 1) PG8_BAR;
    PG8_WAIT_V(2); PG8_BAR;
    PG8_STAGE(PG8_SB(1, 0), cB + kstep, voffB); PG8_STAGE(PG8_SA(1, 0), cA + kstep, cv[0]); PG8_STAGE(PG8_SB(1, 1), cB + hstep + kstep, voffB);
    PG8_WAIT_V(6); PG8_BAR;
    for (;;) {
        const bool has_next = S.next(ui + 1, nxt);
        const char* nA = has_next ? (GATHER ? (const char*)g.A : (const char*)g.A + (size_t)nxt.pm * tstep) : cA; const char* nB = has_next ? (const char*)g.Bt + (size_t)nxt.pn * tstep : cB;
        if (has_next) PG8_IDXDMA(nxt, (ui + 1) & 1);
#pragma unroll
        for (int h = 0; h < 2; ++h)
#pragma unroll
            for (int i = 0; i < 2; ++i) nv[h][i] = cv[h][i];
#pragma unroll 1
        for (int t = 0; t < nt; t += 2) {
            const bool last = (t == nt - 2), relax = (t == 0) && (ui > 0) && (Epi::NST > 0);
            const char* a1 = cA + (size_t)(t + 1) * kstep;
            const char* a2 = last ? nA : cA + (size_t)(t + 2) * kstep; const char* b2 = last ? nB : cB + (size_t)(t + 2) * kstep;
            const char* a3 = a2 + kstep; const char* b3 = b2 + kstep;
            if (last && has_next) { S.a_ready(nxt); PG8_SETV(nv, (ui + 1) & 1); }
            if constexpr (Epi::KSCALE) { if (t == 8 || t == 16) E.kscale(acc, ui, t == 8 ? 0 : 1, wr, fr); }
            if (t == 2) PG8_AUXDMA(cur, ui & 1);
            PG8_SIDE_DMA(sj + 1, 1); PG8_LDB(B0, 0, 0); PG8_LDB(B1, 0, 1); PG8_SCHED; PG8_LDA(At, 0, 0); PG8_STAGE(PG8_SA(1, 1), a1, cv[1]);
            if (last) {
#pragma unroll
                for (int h = 0; h < 2; ++h)
#pragma unroll
                    for (int i = 0; i < 2; ++i) cv[h][i] = nv[h][i]; }
            PG8_WAIT_VKR(relax); PG8_WAIT_L(0); PG8_BAR; PG8_MMA(0, 0, At, B0); PG8_MMA(0, 1, At, B1); PG8_BAR; PG8_SCHED;
            PG8_LDA(At, 0, 1); PG8_SIDE_RD(0); PG8_STAGE(PG8_SB(0, 0), b2, voffB); PG8_STAGE(PG8_SB(0, 1), b2 + hstep, voffB); PG8_STAGE(PG8_SA(0, 0), a2, cv[0]); PG8_SIDE_ST(sj);
            PG8_WAIT_VKR(relax); PG8_WAIT_L(0); PG8_BAR; PG8_MMA(1, 0, At, B0); PG8_MMA(1, 1, At, B1); PG8_BAR; PG8_SCHED;
            PG8_SIDE_DMA(sj + 2, 0); PG8_LDB(B0, 1, 0); PG8_LDB(B1, 1, 1); PG8_SCHED; PG8_LDA(At, 1, 0); PG8_STAGE(PG8_SA(0, 1), a2, cv[1]);
            PG8_WAIT_VK; PG8_WAIT_L(0); PG8_BAR; PG8_MMA(0, 0, At, B0); PG8_MMA(0, 1, At, B1); PG8_BAR; PG8_SCHED;
            PG8_LDA(At, 1, 1); PG8_SIDE_RD(1); PG8_STAGE(PG8_SB(1, 0), b3, voffB); PG8_STAGE(PG8_SB(1, 1), b3 + hstep, voffB); PG8_STAGE(PG8_SA(1, 0), a3, cv[0]); PG8_SIDE_ST(sj + 1);
            PG8_WAIT_VK; PG8_WAIT_L(0); PG8_BAR; PG8_MMA(1, 0, At, B0); PG8_MMA(1, 1, At, B1); PG8_BAR; PG8_SCHED;
            sj += 2;
        }
        if (wr == 0) PG8_BAR;
        E(acc, cur, wr, wc, fr, fq, (const PG8_LAS float*)(idxbuf + 512) + (ui & 1) * 512, ui); S.done(cur);
        if (!has_next) break;
#pragma unroll
        for (int a = 0; a < 2; ++a)
#pragma unroll
            for (int b = 0; b < 2; ++b)
#pragma unroll
                for (int m = 0; m < 4; ++m)
#pragma unroll
                    for (int n = 0; n < 2; ++n) acc[a][b][m][n] = (f32x4){0.f, 0.f, 0.f, 0.f};
        cur = nxt; cA = nA; cB = nB; ++ui;
        if (wr == 1) PG8_BAR;
    }
    PG8_WAIT_V(0);
    PG8_BAR;
#undef PG8_SA
#undef PG8_WAIT_VK
#undef PG8_WAIT_VKR
#undef PG8_SIDE_J
#undef PG8_SIDE_DMA
#undef PG8_SIDE_RD
#undef PG8_SIDE_ST
#undef PG8_SB
#undef PG8_STAGE
#undef PG8_LDA
#undef PG8_LDF
#undef PG8_LDB
#undef PG8_MMA
#undef PG8_WAIT_V
#undef PG8_WAIT_L
#undef PG8_BAR
#undef PG8_SCHED
#undef PG8_SETV
#undef PG8_IDXDMA
#undef PG8_AUXDMA
}

struct EpiBf16Plain {
    static constexpr bool PERM = true, AUX = false, KSCALE = false; static constexpr int NST = 16;
    bf16_t* O; int ldc;
    __device__ __forceinline__ void operator()(const f32x4 (&acc)[2][2][4][2], const Unit& u, int wr, int wc, int fr, int fq, const PG8_LAS float* aux, int ui) const {
        const int row0 = u.pm * BM + wr * 64 + fr, col0 = u.pl * BM + wc * 32 + 8 * fq;
#pragma unroll
        for (int ai = 0; ai < 2; ++ai)
#pragma unroll
            for (int m = 0; m < 4; ++m) { bf16_t* rowp = O + (size_t)(row0 + ai * HALF + m * 16) * ldc + col0;
#pragma unroll
                for (int bj = 0; bj < 2; ++bj) { const f32x4 v0 = acc[ai][bj][m][0], v1 = acc[ai][bj][m][1];
                    u32x4 w; w.x = cvt_pk_bf16(v0[0], v0[1]); w.y = cvt_pk_bf16(v0[2], v0[3]); w.z = cvt_pk_bf16(v1[0], v1[1]); w.w = cvt_pk_bf16(v1[2], v1[3]);
                    *(u32x4*)(rowp + bj * HALF) = w; } }
    }
};
struct EpiProj3 {
    static constexpr bool PERM = true, AUX = false, KSCALE = false; static constexpr int NST = 0;
    bf16_t* P; bf16_t* V;
    __device__ __forceinline__ void operator()(const f32x4 (&acc)[2][2][4][2], const Unit& u, int wr, int wc, int fr, int fq, const PG8_LAS float* aux, int ui) const {
        const bool isv = (u.pl >= 6) && (u.pl < 10);
        bf16_t* O = isv ? V : P; const int ldc = isv ? 1024 : 2048;
        const int colt = u.pl < 6 ? u.pl * BM : (isv ? (u.pl - 6) * BM : 1536 + (u.pl - 10) * BM);
        const int row0 = u.pm * BM + wr * 64 + fr, col0 = colt + wc * 32 + 8 * fq;
#pragma unroll
        for (int ai = 0; ai < 2; ++ai)
#pragma unroll
            for (int m = 0; m < 4; ++m) { bf16_t* rowp = O + (size_t)(row0 + ai * HALF + m * 16) * ldc + col0;
#pragma unroll
                for (int bj = 0; bj < 2; ++bj) { const f32x4 v0 = acc[ai][bj][m][0], v1 = acc[ai][bj][m][1];
                    u32x4 w; w.x = cvt_pk_bf16(v0[0], v0[1]); w.y = cvt_pk_bf16(v0[2], v0[3]); w.z = cvt_pk_bf16(v1[0], v1[1]); w.w = cvt_pk_bf16(v1[2], v1[3]);
                    *(u32x4*)(rowp + bj * HALF) = w; } }
    }
};
struct EpiResBf16 {
    static constexpr bool PERM = true, AUX = false, KSCALE = true; static constexpr int NST = 16;
    const float* base; bf16_t* C; const PG8_LAS float* rq;
    __device__ __forceinline__ void kscale(f32x4 (&acc)[2][2][4][2], int ui, int which, int wr, int fr) const {
#pragma unroll
        for (int ai = 0; ai < 2; ++ai)
#pragma unroll
            for (int m = 0; m < 4; ++m) { const float q = rq[(ui * 256 + ai * HALF + wr * 64 + m * 16 + fr) * 4 + which];
#pragma unroll
                for (int bj = 0; bj < 2; ++bj)
#pragma unroll
                    for (int n = 0; n < 2; ++n) acc[ai][bj][m][n] = acc[ai][bj][m][n] * q; }
    }
    __device__ __forceinline__ void operator()(const f32x4 (&acc)[2][2][4][2], const Unit& u, int wr, int wc, int fr, int fq, const PG8_LAS float* aux, int ui) const {
        const int row0 = u.pm * BM + wr * 64 + fr, col0 = u.pl * BM + wc * 32 + 8 * fq;
#pragma unroll
        for (int ai = 0; ai < 2; ++ai)
#pragma unroll
            for (int m = 0; m < 4; ++m) { const size_t off = (size_t)(row0 + ai * HALF + m * 16) * 1024 + col0; const float q3 = rq[(ui * 256 + ai * HALF + wr * 64 + m * 16 + fr) * 4 + 2];
#pragma unroll
                for (int bj = 0; bj < 2; ++bj) { const f32x4 b0 = __builtin_nontemporal_load((const f32x4*)(base + off + bj * HALF)), b1 = __builtin_nontemporal_load((const f32x4*)(base + off + bj * HALF + 4));
                    const f32x4 v0 = b0 + acc[ai][bj][m][0] * q3, v1 = b1 + acc[ai][bj][m][1] * q3;
                    u32x4 w; w.x = cvt_pk_bf16(v0[0], v0[1]); w.y = cvt_pk_bf16(v0[2], v0[3]); w.z = cvt_pk_bf16(v1[0], v1[1]); w.w = cvt_pk_bf16(v1[2], v1[3]);
                    *(u32x4*)(C + off + bj * HALF) = w; }
                if (m & 1) asm volatile("" ::: "memory"); }
    }
};
typedef float f32x2 __attribute__((ext_vector_type(2)));
__device__ __forceinline__ f32x2 swiglu2(f32x2 g, f32x2 l) {
    g = __builtin_elementwise_min(g, (f32x2){7.0f, 7.0f});
    l = __builtin_elementwise_min(__builtin_elementwise_max(l, (f32x2){-7.0f, -7.0f}), (f32x2){7.0f, 7.0f});
    const f32x2 z = g * (-1.702f * 1.4426950408889634f);
    f32x2 t; t.x = __builtin_amdgcn_exp2f(z.x); t.y = __builtin_amdgcn_exp2f(z.y);
    const f32x2 d = t + 1.0f;
    f32x2 s; s.x = __builtin_amdgcn_rcpf(d.x); s.y = __builtin_amdgcn_rcpf(d.y);
    return (g * s) * (l + 1.0f);
}
struct EpiSwiglu {
    static constexpr bool PERM = true, AUX = true, KSCALE = false; static constexpr int NST = 4;
    unsigned char* act; const float* b_gu; const float* rs; float wscale;
    __device__ __forceinline__ const float* rowsrc(const Unit& u) const { return rs + (size_t)u.pm * BM; }
    __device__ __forceinline__ const float* colsrc(const Unit& u, int w) const { return b_gu + (size_t)u.e * 2048 + (w >> 1) * 1024 + u.pl * HALF + (w & 1) * 64; }
    __device__ __forceinline__ void operator()(const f32x4 (&acc)[2][2][4][2], const Unit& u, int wr, int wc, int fr, int fq, const PG8_LAS float* aux, int ui) const {
        const int row0 = u.pm * BM + wr * 64 + fr, col0 = u.pl * HALF + wc * 32 + 8 * fq;
        const PG8_LAS float* bg = aux + 256 + wc * 32 + 8 * fq;
        const f32x4 g0 = *(const PG8_LAS f32x4*)(bg), g1 = *(const PG8_LAS f32x4*)(bg + 4), l0 = *(const PG8_LAS f32x4*)(bg + 128), l1 = *(const PG8_LAS f32x4*)(bg + 132);
#pragma unroll
        for (int ai = 0; ai < 2; ++ai)
#pragma unroll
            for (int mp = 0; mp < 2; ++mp) {
                unsigned w0[2], w1[2];
#pragma unroll
                for (int mm = 0; mm < 2; ++mm) { const int m = 2 * mp + mm;
                    const float r = aux[ai * HALF + wr * 64 + m * 16 + fr] * wscale;
                    const f32x4 a0 = acc[ai][0][m][0] * r + g0, a1 = acc[ai][0][m][1] * r + g1, b0 = acc[ai][1][m][0] * r + l0, b1 = acc[ai][1][m][1] * r + l1;
                    const f32x2 p0 = swiglu2((f32x2){a0[0], a0[1]}, (f32x2){b0[0], b0[1]}), p1 = swiglu2((f32x2){a0[2], a0[3]}, (f32x2){b0[2], b0[3]});
                    const f32x2 p2 = swiglu2((f32x2){a1[0], a1[1]}, (f32x2){b1[0], b1[1]}), p3 = swiglu2((f32x2){a1[2], a1[3]}, (f32x2){b1[2], b1[3]});
                    w0[mm] = pk_fp8x4(p0.x, p0.y, p1.x, p1.y); w1[mm] = pk_fp8x4(p2.x, p2.y, p3.x, p3.y); }
                const u32x2 s0 = __builtin_amdgcn_permlane16_swap(w0[0], w0[1], false, false), s1 = __builtin_amdgcn_permlane16_swap(w1[0], w1[1], false, false);
                const int row = row0 + ai * HALF + (2 * mp + (fq & 1)) * 16;
                *(u32x4*)(act + (size_t)row * 1024 + u.pl * HALF + wc * 32 + 16 * (fq >> 1)) = (u32x4){s0[0], s1[0], s0[1], s1[1]}; }
    }
};
struct EpiDown {
    static constexpr bool PERM = true, AUX = true, KSCALE = false; static constexpr int NST = 8;
    unsigned char* Y; const float* b_down; const float* gate; float wscale;
    __device__ __forceinline__ const float* rowsrc(const Unit& u) const { return gate + (size_t)u.pm * BM; }
    __device__ __forceinline__ const float* colsrc(const Unit& u, int w) const { return b_down + (size_t)u.e * 1024 + u.pl * BM + w * 64; }
    __device__ __forceinline__ void operator()(const f32x4 (&acc)[2][2][4][2], const Unit& u, int wr, int wc, int fr, int fq, const PG8_LAS float* aux, int ui) const {
        const int row0 = u.pm * BM + wr * 64 + fr, col0 = u.pl * BM + wc * 64 + 16 * fq;
        const PG8_LAS float* bd = aux + 256 + wc * 64 + 16 * fq;
        const f32x4 b00 = *(const PG8_LAS f32x4*)(bd), b01 = *(const PG8_LAS f32x4*)(bd + 4), b10 = *(const PG8_LAS f32x4*)(bd + 8), b11 = *(const PG8_LAS f32x4*)(bd + 12);
#pragma unroll
        for (int ai = 0; ai < 2; ++ai)
#pragma unroll
            for (int m = 0; m < 4; ++m) { const int rl = ai * HALF + wr * 64 + m * 16 + fr; const float gt = aux[rl] * 16.0f;
                const f32x4 lim = {440.f, 440.f, 440.f, 440.f};
                const f32x4 v0 = __builtin_elementwise_min(__builtin_elementwise_max((acc[ai][0][m][0] * wscale + b00) * gt, -lim), lim), v1 = __builtin_elementwise_min(__builtin_elementwise_max((acc[ai][0][m][1] * wscale + b01) * gt, -lim), lim),
                            v2 = __builtin_elementwise_min(__builtin_elementwise_max((acc[ai][1][m][0] * wscale + b10) * gt, -lim), lim), v3 = __builtin_elementwise_min(__builtin_elementwise_max((acc[ai][1][m][1] * wscale + b11) * gt, -lim), lim);
                u32x4 w; w.x = pk_fp8x4(v0[0], v0[1], v0[2], v0[3]); w.y = pk_fp8x4(v1[0], v1[1], v1[2], v1[3]); w.z = pk_fp8x4(v2[0], v2[1], v2[2], v2[3]); w.w = pk_fp8x4(v3[0], v3[1], v3[2], v3[3]);
                *(u32x4*)(Y + (size_t)(u.pm * BM + rl) * 1024 + col0) = w; }
    }
};
}
using pg8::pk_fp8x4;

__device__ __forceinline__ void transpose_load(const float* W, int ldw, int k0, int n0, float scale, LAS float* scr, int lane, const float* rowscale = nullptr) {
    float4 r[8]; float rsc[8];
#pragma unroll
    for (int i = 0; i < 8; ++i) { r[i] = ld_nt_f4(W + (size_t)(k0 + 8 * i + (lane >> 3)) * ldw + n0 + 4 * (lane & 7)); rsc[i] = rowscale ? rowscale[k0 + 8 * i + (lane >> 3)] * scale : scale; }
#pragma unroll
    for (int i = 0; i < 8; ++i) { LAS float* d = scr + (8 * i + (lane >> 3)) * 33 + 4 * (lane & 7); d[0] = r[i].x * rsc[i]; d[1] = r[i].y * rsc[i]; d[2] = r[i].z * rsc[i]; d[3] = r[i].w * rsc[i]; }
    asm volatile("s_waitcnt lgkmcnt(0)" ::: "memory");
}
__device__ __forceinline__ void transpose_item(const float* W, int ldw, int K, bf16* WT, int rowbase, int k0, int n0, LAS float* scr, int lane, const float* rowscale = nullptr) {
    transpose_load(W, ldw, k0, n0, 1.0f, scr, lane, rowscale);
    const int c = lane & 7;
#pragma unroll
    for (int j = 0; j < 4; ++j) { const int n = (lane >> 3) + 8 * j; const LAS float* s = scr + (8 * c) * 33 + n;
        uint4 o; o.x = pkbf(s[0 * 33], s[1 * 33]); o.y = pkbf(s[2 * 33], s[3 * 33]); o.z = pkbf(s[4 * 33], s[5 * 33]); o.w = pkbf(s[6 * 33], s[7 * 33]);
        *(uint4*)(WT + (size_t)(rowbase + n) * K + k0 + 8 * c) = o; }
    asm volatile("s_waitcnt lgkmcnt(0)" ::: "memory");
}

__device__ __forceinline__ void transpose_item_fp8(const float* W, int ldw, int K, unsigned char* WT, int rowbase, int k0, int n0, float scale, LAS float* scr, int lane) {
    transpose_load(W, ldw, k0, n0, scale, scr, lane);
    const int c = lane & 7;
#pragma unroll
    for (int j = 0; j < 4; ++j) { const int n = (lane >> 3) + 8 * j; const LAS float* s = scr + (8 * c) * 33 + n;
        uint2 o; o.x = pk_fp8x4(s[0 * 33], s[1 * 33], s[2 * 33], s[3 * 33]); o.y = pk_fp8x4(s[4 * 33], s[5 * 33], s[6 * 33], s[7 * 33]);
        *(uint2*)(WT + (size_t)(rowbase + n) * K + k0 + 8 * c) = o; }
    asm volatile("s_waitcnt lgkmcnt(0)" ::: "memory");
}

struct XDesc { const float* W; unsigned char* WT; int ldw, rowbase, k0, n0, perm; };
__device__ __forceinline__ XDesc xdesc(int r, const float* w_gu, const float* w_down, unsigned char* WguT, unsigned char* WdT) {
    XDesc d;
    if (r < 16384) { const int e = r >> 9, q = r & 511, kb = q >> 6, nb = q & 63, n0 = nb * 32;
        d.W = w_gu + (size_t)e * 1024 * 2048; d.WT = WguT; d.ldw = 2048; d.k0 = kb * 128; d.n0 = n0;
        d.rowbase = e * 2048 + ((n0 & 1023) >> 7) * 256 + (n0 >> 10) * 128 + (n0 & 127); d.perm = 0; }
    else { const int r2 = r - 16384, e = r2 >> 8, q = r2 & 255, kb = q >> 5, nb = q & 31;
        d.W = w_down + (size_t)e * 1024 * 1024; d.WT = WdT; d.ldw = 1024; d.k0 = kb * 128; d.n0 = nb * 32; { const int c0 = (nb * 32) & 255; d.rowbase = e * 1024 + ((nb * 32) & ~255) + 32 * (c0 >> 6) + 8 * ((c0 >> 4) & 3); } d.perm = 1; }
    return d;
}
__device__ __forceinline__ void xload(const XDesc& d, float4 (&r)[16], int lane) {
#pragma unroll
    for (int i = 0; i < 16; ++i) { const pg8::f32x4 t_ = __builtin_nontemporal_load((const pg8::f32x4*)(d.W + (size_t)(d.k0 + 8 * i + (lane >> 3)) * d.ldw + d.n0 + 4 * (lane & 7))); r[i] = make_float4(t_[0], t_[1], t_[2], t_[3]); }
}
__device__ __forceinline__ void xstore(const XDesc& d, const float4 (&r)[16], float scale, LAS float* scr, int lane) {
#pragma unroll
    for (int i = 0; i < 16; ++i) { LAS float* o = scr + (8 * i + (lane >> 3)) * 33 + 4 * (lane & 7); o[0] = r[i].x * scale; o[1] = r[i].y * scale; o[2] = r[i].z * scale; o[3] = r[i].w * scale; }
    asm volatile("s_waitcnt lgkmcnt(0)" ::: "memory");
    const int c = lane & 15;
#pragma unroll
    for (int j = 0; j < 8; ++j) { const int n = (lane >> 4) + 4 * j; const LAS float* s = scr + (8 * c) * 33 + n;
        uint2 o; o.x = pk_fp8x4(s[0 * 33], s[1 * 33], s[2 * 33], s[3 * 33]); o.y = pk_fp8x4(s[4 * 33], s[5 * 33], s[6 * 33], s[7 * 33]);
        const int row = d.rowbase + (d.perm ? 128 * ((n >> 3) & 1) + 8 * (n >> 4) + (n & 7) : n);
        *(uint2*)(d.WT + (size_t)row * 1024 + d.k0 + 8 * c) = o; }
    asm volatile("s_waitcnt lgkmcnt(0)" ::: "memory");
}

__device__ __forceinline__ void rms_row_bf16(const float* xr, const float* g, bf16* o, int lane, float4 (&v)[4]) {
    float s = 0.f;
#pragma unroll
    for (int j = 0; j < 4; ++j) { v[j] = ((const float4*)xr)[lane + 64 * j]; s += v[j].x * v[j].x + v[j].y * v[j].y + v[j].z * v[j].z + v[j].w * v[j].w; }
    s = wave_sum(s);
    const float rs = 1.0f / sqrtf(s * (1.0f / 1024.0f) + 1e-6f);
#pragma unroll
    for (int j = 0; j < 4; ++j) { const float4 gg = ((const float4*)g)[lane + 64 * j];
        v[j].x *= rs * gg.x; v[j].y *= rs * gg.y; v[j].z *= rs * gg.z; v[j].w *= rs * gg.w;
        ((uint2*)o)[lane + 64 * j] = make_uint2(pk2(v[j].x, v[j].y), pk2(v[j].z, v[j].w)); }
}
__device__ __forceinline__ void rms_row(const float* xr, const float* g, float* o, int lane, float4 (&v)[4]) {
    float s = 0.f;
#pragma unroll
    for (int j = 0; j < 4; ++j) { v[j] = ((const float4*)xr)[lane + 64 * j]; s += v[j].x * v[j].x + v[j].y * v[j].y + v[j].z * v[j].z + v[j].w * v[j].w; }
    s = wave_sum(s);
    const float rs = 1.0f / sqrtf(s * (1.0f / 1024.0f) + 1e-6f);
#pragma unroll
    for (int j = 0; j < 4; ++j) { const float4 gg = ((const float4*)g)[lane + 64 * j];
        v[j].x *= rs * gg.x; v[j].y *= rs * gg.y; v[j].z *= rs * gg.z; v[j].w *= rs * gg.w; ((float4*)o)[lane + 64 * j] = v[j]; }
}
typedef short bf16x8 __attribute__((ext_vector_type(8)));
typedef short s16x4 __attribute__((ext_vector_type(4)));
typedef float f32x4 __attribute__((ext_vector_type(4)));
typedef LAS s16x4 lds_s16x4;
typedef unsigned u32x4_t __attribute__((ext_vector_type(4)));
typedef unsigned u32x2_w __attribute__((ext_vector_type(2)));
#define MFMA16(a, b, c) __builtin_amdgcn_mfma_f32_16x16x32_bf16((a), (b), (c), 0, 0, 0)
__device__ __forceinline__ bf16x8 tr_frag(const LAS unsigned char* p0, const LAS unsigned char* p1) {
    const s16x4 a = __builtin_amdgcn_ds_read_tr16_b64_v4i16((lds_s16x4*)p0), b = __builtin_amdgcn_ds_read_tr16_b64_v4i16((lds_s16x4*)p1);
    return __builtin_shufflevector(a, b, 0, 1, 2, 3, 4, 5, 6, 7);
}
__device__ __forceinline__ bf16x8 pack8(const f32x4 a, const f32x4 b) {
    uint4 u; u.x = pkbf(a[0], a[1]); u.y = pkbf(a[2], a[3]); u.z = pkbf(b[0], b[1]); u.w = pkbf(b[2], b[3]); return __builtin_bit_cast(bf16x8, u);
}

constexpr int MA_PITCH = 272, MA_VOFF = 256 * MA_PITCH;
__device__ __forceinline__ void mem_attn_phase(LAS unsigned char* L, const bf16* projb, const bf16* kmem, const bf16* vmem, bf16* ycr, float* pss, int bid, int G) {
    int tid = threadIdx.x; asm volatile("" : "+v"(tid));
    const int lane = tid & 63, wave = __builtin_amdgcn_readfirstlane(tid >> 6), fr = lane & 15, g = lane >> 4, q = fr >> 2, pp = lane & 3;
    for (int u = bid; u < 256; u += G) {
        const int bh = u >> 4, chunk = u & 15, b = bh >> 2, hm = bh & 3;
        __syncthreads();
        {
            const u32x4_t* ksrc = (const u32x4_t*)(kmem + (size_t)bh * 256 * 128); const u32x4_t* vsrc = (const u32x4_t*)(vmem + (size_t)bh * 256 * 128);
            u32x4_t kr[8], vr[8];
#pragma unroll
            for (int i = 0; i < 8; ++i) { kr[i] = ksrc[tid + 512 * i]; vr[i] = vsrc[tid + 512 * i]; }
#pragma unroll
            for (int i = 0; i < 8; ++i) { const int pc = tid + 512 * i, row = pc >> 4, ch = pc & 15;
                *(LAS u32x4_t*)(L + row * MA_PITCH + ch * 16) = kr[i]; *(LAS u32x4_t*)(L + MA_VOFF + row * MA_PITCH + ch * 16) = vr[i]; }
        }
        __syncthreads();
        for (int ti = wave; ti < 32; ti += 8) {
            const int tok = (b << 13) + chunk * 512 + ti * 16 + fr;
            bf16x8 qf[4];
#pragma unroll
            for (int kc = 0; kc < 4; ++kc) qf[kc] = __builtin_nontemporal_load((const bf16x8*)(projb + (size_t)tok * PW + 2048 + hm * 128 + 32 * kc + 8 * g));
            f32x4 s[16];
#pragma unroll
            for (int kb = 0; kb < 16; ++kb) { s[kb] = (f32x4){0.f, 0.f, 0.f, 0.f};
#pragma unroll
                for (int kc = 0; kc < 4; ++kc) { const bf16x8 kf = *(const LAS bf16x8*)(L + (16 * kb + fr) * MA_PITCH + (32 * kc + 8 * g) * 2); s[kb] = MFMA16(kf, qf[kc], s[kb]); }
                if (kb & 1) __builtin_amdgcn_sched_barrier(0); }
            const float sc = 0.08838834764831845f * 1.4426950408889634f;
            float mx = -3.0e38f;
#pragma unroll
            for (int kb = 0; kb < 16; ++kb) { s[kb] = s[kb] * sc; mx = fmaxf(mx, fmaxf(fmaxf(s[kb][0], s[kb][1]), fmaxf(s[kb][2], s[kb][3]))); }
            mx = fmaxf(mx, __shfl_xor(mx, 16)); mx = fmaxf(mx, __shfl_xor(mx, 32));
            float sum = 0.f;
#pragma unroll
            for (int kb = 0; kb < 16; ++kb) {
#pragma unroll
                for (int i = 0; i < 4; ++i) { const float e = __builtin_amdgcn_exp2f(s[kb][i] - mx); s[kb][i] = e; sum += e; } }
            sum += __shfl_xor(sum, 16); sum += __shfl_xor(sum, 32);
            f32x4 o[8];
#pragma unroll
            for (int db = 0; db < 8; ++db) o[db] = (f32x4){0.f, 0.f, 0.f, 0.f};
#pragma unroll
            for (int c = 0; c < 8; ++c) {
                const bf16x8 pf = pack8(s[2 * c], s[2 * c + 1]);
                const LAS unsigned char* vb = L + MA_VOFF + (32 * c + 4 * g + q) * MA_PITCH + 8 * pp;
#pragma unroll
                for (int db = 0; db < 8; ++db) { const bf16x8 vf = tr_frag(vb + 32 * db, vb + 16 * MA_PITCH + 32 * db); o[db] = MFMA16(vf, pf, o[db]); }
                __builtin_amdgcn_sched_barrier(0);
            }
            const float inv = 1.0f / sum;
            bf16* orow0 = ycr + (size_t)tok * MIXW + 1024 + hm * 128;
            float ss = 0.f;
#pragma unroll
            for (int dp = 0; dp < 4; ++dp) { unsigned x0[2], x1[2];
#pragma unroll
                for (int t = 0; t < 2; ++t) { const f32x4 v = o[2 * dp + t] * inv; ss += (v[0] * v[0] + v[1] * v[1]) + (v[2] * v[2] + v[3] * v[3]); x0[t] = pkbf(v[0], v[1]); x1[t] = pkbf(v[2], v[3]); }
                const u32x2_w s0 = __builtin_amdgcn_permlane16_swap(x0[0], x0[1], false, false), s1 = __builtin_amdgcn_permlane16_swap(x1[0], x1[1], false, false);
                *(u32x4_t*)(orow0 + 16 * (2 * dp + (g & 1)) + 8 * (g >> 1)) = (u32x4_t){s0[0], s1[0], s0[1], s1[1]}; }
            ss += __shfl_xor(ss, 16); ss += __shfl_xor(ss, 32);
            if (g == 0) pss[(size_t)tok * 12 + 8 + hm] = ss;
        }
    }
    __syncthreads();
}

constexpr int NA_PITCH = 144, NA_VOFF = 512 * NA_PITCH, NA_BOFF = 2 * 512 * NA_PITCH;
__device__ __forceinline__ void na_attn_phase(LAS unsigned char* L, const bf16* projb, const float* rel_bias, bf16* ycr, float* pss, int bid, int G) {
    int tid = threadIdx.x; asm volatile("" : "+v"(tid));
    const int lane = tid & 63, wave = __builtin_amdgcn_readfirstlane(tid >> 6), fr = lane & 15, g = lane >> 4, q = fr >> 2, pp = lane & 3;
    LAS float* bias_s = (LAS float*)(L + NA_BOFF);
    for (int sq = bid; sq < 256; sq += G) {
        const int qb = sq & 3, h = (sq >> 2) & 7, half = (sq >> 5) & 1, b = sq >> 6;
        const int c0 = qb == 0 ? 0 : qb == 1 ? 8 : qb == 2 ? 24 : 32;
        __syncthreads();
        {
            const int r0 = 64 * half, wr0 = min(max(r0 - 4, 0), 120), wr1 = min(r0 + 3, 120) + 7, nrows = wr1 - wr0 + 1;
            u32x4_t rg[15];
#pragma unroll
            for (int i = 0; i < 15; ++i) {
                if (i < nrows) { const int cc = tid >> 4, part = tid & 15, isv = part >> 3, ch = part & 7;
                    const int tok = (b << 13) + (wr0 + i) * 64 + c0 + cc;
                    rg[i] = *(const u32x4_t*)(projb + (size_t)tok * PW + (isv ? 1024 : 512) + h * 64 + ch * 8); } }
#pragma unroll
            for (int i = 0; i < 15; ++i) {
                if (i < nrows) { const int cc = tid >> 4, part = tid & 15, isv = part >> 3, ch = part & 7;
                    *(LAS u32x4_t*)(L + (isv ? NA_VOFF : 0) + (((wr0 + i) & 15) * 32 + cc) * NA_PITCH + ch * 16) = rg[i]; } }
            if (tid < 465) bias_s[16 + tid] = rel_bias[h * 465 + tid] * 1.4426950408889634f;
        }
        for (int i8 = 0; i8 < 8; ++i8) {
            const int ro = 8 * half + i8, r0 = 8 * ro, wr1 = min(r0 + 3, 120) + 7;
            const int nnew = i8 < 7 ? (min(r0 + 11, 120) + 7) - wr1 : 0;
            __syncthreads();
            const int r = r0 + wave, rs = min(max(r - 4, 0), 120);
            const int cq = 16 * qb + fr, cs = min(max(cq - 8, 0), 48);
            const int tok = (b << 13) + r * 64 + cq;
            bf16x8 qf[2];
#pragma unroll
            for (int kc = 0; kc < 2; ++kc) qf[kc] = __builtin_nontemporal_load((const bf16x8*)(projb + (size_t)tok * PW + h * 64 + 32 * kc + 8 * g));
            asm volatile("" ::: "memory");
            u32x4_t rn[8];
#pragma unroll
            for (int i = 0; i < 8; ++i) { const int lr = i < nnew ? i : (nnew > 0 ? nnew - 1 : 0), key = tid >> 4, part = tid & 15, isv = part >> 3, ch = part & 7;
                const int tokn = (b << 13) + min(wr1 + 1 + lr, 127) * 64 + c0 + key;
                rn[i] = *(const u32x4_t*)(projb + (size_t)tokn * PW + (isv ? 1024 : 512) + h * 64 + ch * 8); }
            f32x4 s[16];
            float bv[8][4], bw[8][4];
            const LAS float* bp0 = bias_s + 16 + (rs - r + 7) * 31 + 15 + (c0 + 4 * g - cq);
#pragma unroll
            for (int kq = 0; kq < 4; ++kq) {
                bf16x8 kf[4][2];
#pragma unroll
                for (int kk = 0; kk < 4; ++kk) { const int kb = 4 * kq + kk;
                    const LAS unsigned char* kp = L + ((((rs + (kb >> 1)) & 15)) * 32 + 16 * (kb & 1) + fr) * NA_PITCH + 16 * g;
                    kf[kk][0] = *(const LAS bf16x8*)kp; kf[kk][1] = *(const LAS bf16x8*)(kp + 64); }
                if (kq == 0) {
#pragma unroll
                    for (int kb = 0; kb < 8; ++kb)
#pragma unroll
                        for (int i = 0; i < 4; ++i) bv[kb][i] = bp0[16 * (kb & 1) + 31 * (kb >> 1) + i]; }
                __builtin_amdgcn_sched_barrier(0);
#pragma unroll
                for (int kk = 0; kk < 4; ++kk) { const int kb = 4 * kq + kk; s[kb] = MFMA16(kf[kk][0], qf[0], ((f32x4){0.f, 0.f, 0.f, 0.f})); s[kb] = MFMA16(kf[kk][1], qf[1], s[kb]); }
                __builtin_amdgcn_sched_barrier(0);
            }
            bool okc[2][4];
#pragma unroll
            for (int hf = 0; hf < 2; ++hf)
#pragma unroll
                for (int i = 0; i < 4; ++i) { const int ck = c0 + 16 * hf + 4 * g + i; okc[hf][i] = (ck >= cs) && (ck < cs + 16); }
#pragma unroll
            for (int kb = 8; kb < 16; ++kb)
#pragma unroll
                for (int i = 0; i < 4; ++i) bw[kb - 8][i] = bp0[16 * (kb & 1) + 31 * (kb >> 1) + i];
            __builtin_amdgcn_sched_barrier(0);
            float mx = -3.0e38f;
#pragma unroll
            for (int kb = 0; kb < 16; ++kb) {
                const int hf = kb & 1;
#pragma unroll
                for (int i = 0; i < 4; ++i) { const float v = okc[hf][i] ? fmaf(s[kb][i], 0.125f * 1.4426950408889634f, kb < 8 ? bv[kb][i] : bw[kb - 8][i]) : -3.0e38f; s[kb][i] = v; mx = fmaxf(mx, v); } }
            mx = fmaxf(mx, __shfl_xor(mx, 16)); mx = fmaxf(mx, __shfl_xor(mx, 32));
            float sum = 0.f;
#pragma unroll
            for (int kb = 0; kb < 16; ++kb) {
#pragma unroll
                for (int i = 0; i < 4; ++i) { const float e = __builtin_amdgcn_exp2f(s[kb][i] - mx); s[kb][i] = e; sum += e; } }
            sum += __shfl_xor(sum, 16); sum += __shfl_xor(sum, 32);
            f32x4 o[4];
#pragma unroll
            for (int db = 0; db < 4; ++db) o[db] = (f32x4){0.f, 0.f, 0.f, 0.f};
#pragma unroll
            for (int jp = 0; jp < 4; ++jp) {
                bf16x8 vf[2][4];
#pragma unroll
                for (int jj = 0; jj < 2; ++jj) { const int j = 2 * jp + jj;
                    const LAS unsigned char* vb = L + NA_VOFF + (((rs + j) & 15) * 32 + 4 * g + q) * NA_PITCH + 8 * pp;
#pragma unroll
                    for (int db = 0; db < 4; ++db) vf[jj][db] = tr_frag(vb + 32 * db, vb + 16 * NA_PITCH + 32 * db); }
                __builtin_amdgcn_sched_barrier(0);
#pragma unroll
                for (int jj = 0; jj < 2; ++jj) { const int j = 2 * jp + jj; const bf16x8 pf = pack8(s[2 * j], s[2 * j + 1]);
#pragma unroll
                    for (int db = 0; db < 4; ++db) o[db] = MFMA16(vf[jj][db], pf, o[db]); }
                __builtin_amdgcn_sched_barrier(0);
            }
            const float inv = 1.0f / sum;
            bf16* orow0 = ycr + (size_t)tok * MIXW + h * 64;
            float ss = 0.f;
#pragma unroll
            for (int dp = 0; dp < 2; ++dp) { unsigned x0[2], x1[2];
#pragma unroll
                for (int t = 0; t < 2; ++t) { const f32x4 v = o[2 * dp + t] * inv; ss += (v[0] * v[0] + v[1] * v[1]) + (v[2] * v[2] + v[3] * v[3]); x0[t] = pkbf(v[0], v[1]); x1[t] = pkbf(v[2], v[3]); }
                const u32x2_w s0 = __builtin_amdgcn_permlane16_swap(x0[0], x0[1], false, false), s1 = __builtin_amdgcn_permlane16_swap(x1[0], x1[1], false, false);
                *(u32x4_t*)(orow0 + 16 * (2 * dp + (g & 1)) + 8 * (g >> 1)) = (u32x4_t){s0[0], s1[0], s0[1], s1[1]}; }
            ss += __shfl_xor(ss, 16); ss += __shfl_xor(ss, 32);
            if (g == 0) pss[(size_t)tok * 12 + h] = ss;
            __syncthreads();
#pragma unroll
            for (int i = 0; i < 8; ++i)
                if (i < nnew) { const int key = tid >> 4, part = tid & 15, isv = part >> 3, ch = part & 7;
                    *(LAS u32x4_t*)(L + (isv ? NA_VOFF : 0) + (((wr1 + 1 + i) & 15) * 32 + key) * NA_PITCH + ch * 16) = rn[i]; }
        }
    }
    __syncthreads();
}
typedef unsigned u32x2_t __attribute__((ext_vector_type(2)));
constexpr int FT_PITCH = 528, FT_OS1 = 128 * FT_PITCH;
constexpr int FT_UP = 272;
__device__ __forceinline__ void ft_stage1_phase(LAS unsigned char* L, const bf16* projb, bf16* Mid, const bf16* tabC, const bf16* tabS, const bf16* tabSn, const float2* tab8192, int bid, int G) {
    int tid = threadIdx.x; asm volatile("" : "+v"(tid));
    const int lane = tid & 63, wave = __builtin_amdgcn_readfirstlane(tid >> 6), fr = lane & 15, g4 = lane >> 4, q = fr >> 2, pp = lane & 3;
    bf16x8 fC[4], fS[4], fSn[4], fD[2][4];
#pragma unroll
    for (int kc = 0; kc < 4; ++kc) { const size_t o = (size_t)(16 * wave + fr) * 128 + 32 * kc + 8 * g4; fC[kc] = *(const bf16x8*)(tabC + o); fS[kc] = *(const bf16x8*)(tabS + o); fSn[kc] = *(const bf16x8*)(tabSn + o);
#pragma unroll
        for (int t = 0; t < 2; ++t) { const int nb = 2 * wave + t; const bf16* tb = nb < 8 ? tabC : tabSn; fD[t][kc] = *(const bf16x8*)(tb + (size_t)(16 * (nb & 7) + fr) * 128 + 32 * kc + 8 * g4); } }
#define FT1_LOAD(uu) do { const int _g = (uu) & 3, _c = ((uu) >> 2) & 63, _b = (uu) >> 8; _Pragma("unroll") for (int i = 0; i < 4; ++i) { const int r = (tid >> 4) + 32 * i, ch = tid & 15; \
        rg[i] = __builtin_nontemporal_load((const u32x4_t*)(projb + (size_t)((_b << 13) + 64 * r + _c) * PW + 1536 + _g * 128 + ch * 8)); } } while (0)
    u32x4_t rg[4];
    if (bid < 1024) FT1_LOAD(bid);
    for (int u = bid; u < 1024; u += G) {
        const int g = u & 3, c = (u >> 2) & 63, b = u >> 8;
#pragma unroll
        for (int i = 0; i < 4; ++i) { const int r = (tid >> 4) + 32 * i, ch = tid & 15; *(LAS u32x4_t*)(L + FT_OS1 + r * FT_UP + ch * 16) = rg[i]; }
        __syncthreads();
        { const int un = u + G < 1024 ? u + G : u; FT1_LOAD(un); }
        {
#pragma unroll
            for (int mb = 0; mb < 8; ++mb) {
                f32x4 v0 = {0.f, 0.f, 0.f, 0.f}, v1 = {0.f, 0.f, 0.f, 0.f};
#pragma unroll
                for (int kc = 0; kc < 4; ++kc) { const bf16x8 bu = *(const LAS bf16x8*)(L + FT_OS1 + (16 * mb + fr) * FT_UP + (32 * kc + 8 * g4) * 2);
                    v0 = MFMA16(fD[0][kc], bu, v0); v1 = MFMA16(fD[1][kc], bu, v1); }
                LAS unsigned char* xr = L + (16 * mb + fr) * FT_PITCH + (32 * wave + 4 * g4) * 2;
                *(LAS u32x2_t*)(xr) = (u32x2_t){pkbf(v0[0], v0[1]), pkbf(v0[2], v0[3])};
                *(LAS u32x2_t*)(xr + 32) = (u32x2_t){pkbf(v1[0], v1[1]), pkbf(v1[2], v1[3])};
            }
        }
        __syncthreads();
        {
            const int k1 = 16 * wave + fr;
            const float2 tw = tab8192[k1 * c];
            LAS unsigned char* orow = L + FT_OS1 + k1 * FT_PITCH + 8 * g4;
#pragma unroll
            for (int nb = 0; nb < 8; ++nb) {
                f32x4 re = {0.f, 0.f, 0.f, 0.f}, im = {0.f, 0.f, 0.f, 0.f};
#pragma unroll
                for (int kc = 0; kc < 4; ++kc) {
                    const LAS unsigned char* xp = L + (32 * kc + 8 * g4 + q) * FT_PITCH + 32 * nb + 8 * pp;
                    const bf16x8 ar = tr_frag(xp, xp + 4 * FT_PITCH), ai = tr_frag(xp + 256, xp + 256 + 4 * FT_PITCH);
                    re = MFMA16(ar, fC[kc], re); re = MFMA16(ai, fS[kc], re); im = MFMA16(ai, fC[kc], im); im = MFMA16(ar, fSn[kc], im);
                }
                const f32x4 ore = re * tw.x + im * tw.y, oim = im * tw.x - re * tw.y;
                *(LAS u32x2_t*)(orow + 32 * nb) = (u32x2_t){pkbf(ore[0], ore[1]), pkbf(ore[2], ore[3])};
                *(LAS u32x2_t*)(orow + 256 + 32 * nb) = (u32x2_t){pkbf(oim[0], oim[1]), pkbf(oim[2], oim[3])};
                __builtin_amdgcn_sched_barrier(0);
            }
        }
        __syncthreads();
        {
#pragma unroll
            for (int i = 0; i < 8; ++i) { const int pc = tid + 512 * i, k1 = pc >> 5, ch = pc & 31;
                *(u32x4_t*)(Mid + ((size_t)(((b * 128 + k1) * 4 + g) * 64 + c)) * 256 + ch * 8) = *(const LAS u32x4_t*)(L + FT_OS1 + k1 * FT_PITCH + ch * 16); }
        }
        __syncthreads();
    }
    __syncthreads();
#undef FT1_LOAD
}
constexpr int FT_XS2 = 64 * FT_PITCH, FT_OS2 = 2 * FT_XS2, FT_OP2 = 1040;
__device__ __forceinline__ void ft_stage2_phase(LAS unsigned char* L, const bf16* Mid, bf16* yout, const bf16* tab2, float* pss2, int bid, int G) {
    int tid = threadIdx.x; asm volatile("" : "+v"(tid));
    const int lane = tid & 63, wave = __builtin_amdgcn_readfirstlane(tid >> 6), fr = lane & 15, g4 = lane >> 4, q = fr >> 2, pp = lane & 3;
    bf16x8 fT[4][4];
#pragma unroll
    for (int kb = 0; kb < 4; ++kb)
#pragma unroll
        for (int kc = 0; kc < 4; ++kc) fT[kb][kc] = *(const bf16x8*)(tab2 + (size_t)(16 * kb + fr) * 128 + 32 * kc + 8 * g4);
    for (int u = bid; u < 512; u += G) {
        const int k1 = u & 127, b = u >> 7;
        const bf16* src = Mid + (size_t)((b * 128 + k1) * 4) * 64 * 256;
        u32x4_t rg[4];
#pragma unroll
        for (int i = 0; i < 4; ++i) rg[i] = __builtin_nontemporal_load((const u32x4_t*)(src + (size_t)(tid + 512 * i) * 8));
#pragma unroll
        for (int i = 0; i < 4; ++i) { const int pc = tid + 512 * i, c = pc >> 5, ch = pc & 31; *(LAS u32x4_t*)(L + c * FT_PITCH + ch * 16) = rg[i]; }
        __syncthreads();
#pragma unroll
        for (int g = 0; g < 4; ++g) {
            if (g < 3) {
#pragma unroll
                for (int i = 0; i < 4; ++i) rg[i] = __builtin_nontemporal_load((const u32x4_t*)(src + (size_t)(g + 1) * 64 * 256 + (size_t)(tid + 512 * i) * 8));
            }
            const LAS unsigned char* X = L + (g & 1) * FT_XS2;
            f32x4 acc[4];
#pragma unroll
            for (int kb = 0; kb < 4; ++kb) acc[kb] = (f32x4){0.f, 0.f, 0.f, 0.f};
#pragma unroll
            for (int kc = 0; kc < 4; ++kc) {
                const LAS unsigned char* xp = X + (32 * (kc & 1) + 8 * g4 + q) * FT_PITCH + (kc >> 1) * 256 + 32 * wave + 8 * pp;
                const bf16x8 a = tr_frag(xp, xp + 4 * FT_PITCH);
#pragma unroll
                for (int kb = 0; kb < 4; ++kb) acc[kb] = MFMA16(a, fT[kb][kc], acc[kb]);
            }
#pragma unroll
            for (int kb = 0; kb < 4; ++kb) { const f32x4 v = acc[kb] * (1.0f / 1024.0f);
                *(LAS u32x2_t*)(L + FT_OS2 + (16 * kb + fr) * FT_OP2 + (g * 128 + 16 * wave + 4 * g4) * 2) = (u32x2_t){pkbf(v[0], v[1]), pkbf(v[2], v[3])}; }
            if (g < 3) {
#pragma unroll
                for (int i = 0; i < 4; ++i) { const int pc = tid + 512 * i, c = pc >> 5, ch = pc & 31; *(LAS u32x4_t*)(L + ((g + 1) & 1) * FT_XS2 + c * FT_PITCH + ch * 16) = rg[i]; }
            }
            __syncthreads();
        }
#pragma unroll
        for (int j = 0; j < 8; ++j) {
            const int k2 = 8 * wave + j;
            const u32x4_t raw = *(const LAS u32x4_t*)(L + FT_OS2 + k2 * FT_OP2 + lane * 16);
            float f0 = __builtin_bit_cast(float, raw.x << 16), f1 = __builtin_bit_cast(float, raw.x & 0xffff0000u), f2 = __builtin_bit_cast(float, raw.y << 16), f3 = __builtin_bit_cast(float, raw.y & 0xffff0000u);
            float f4 = __builtin_bit_cast(float, raw.z << 16), f5 = __builtin_bit_cast(float, raw.z & 0xffff0000u), f6 = __builtin_bit_cast(float, raw.w << 16), f7 = __builtin_bit_cast(float, raw.w & 0xffff0000u);
            float s = (f0 * f0 + f1 * f1) + (f2 * f2 + f3 * f3) + (f4 * f4 + f5 * f5) + (f6 * f6 + f7 * f7);
            s = wave_sum(s);
            const size_t tok = (size_t)((b << 13) + k1 + 128 * k2);
            *(u32x4_t*)(yout + tok * MIXW + 512 + lane * 8) = raw;
            if (lane == 0) pss2[tok] = s;
        }
    }
    __syncthreads();
}

template <class AF, class BF>
__device__ __forceinline__ void naive_tile(float* sm, int K, AF af, BF bf, float (&acc)[8][4]) {
    float (*As)[132] = (float (*)[132])sm; float (*Bs)[132] = (float (*)[132])(sm + 16 * 132);
    const int tid = threadIdx.x, tx = tid & 31, ty = tid >> 5;
#pragma unroll
    for (int i = 0; i < 8; ++i)
#pragma unroll
        for (int j = 0; j < 4; ++j) acc[i][j] = 0.f;
    for (int k0 = 0; k0 < K; k0 += 16) {
        { const int r = tid >> 2, kk = (tid & 3) * 4;
#pragma unroll
          for (int j = 0; j < 4; ++j) As[kk + j][r] = af(r, k0 + kk + j); }
        { const int kk = tid >> 5, c = (tid & 31) * 4;
#pragma unroll
          for (int j = 0; j < 4; ++j) Bs[kk][c + j] = bf(k0 + kk, c + j); }
        __syncthreads();
#pragma unroll
        for (int kk = 0; kk < 16; ++kk) {
            float a[8], b[4];
#pragma unroll
            for (int i = 0; i < 8; ++i) a[i] = As[kk][ty * 8 + i];
#pragma unroll
            for (int j = 0; j < 4; ++j) b[j] = Bs[kk][(j >> 1) * 64 + tx * 2 + (j & 1)];
#pragma unroll
            for (int i = 0; i < 8; ++i)
#pragma unroll
                for (int j = 0; j < 4; ++j) acc[i][j] += a[i] * b[j];
        }
        __syncthreads();
    }
}

#define PHASE_IDS int tid_ = threadIdx.x; asm volatile("" : "+v"(tid_)); const int tid = tid_, lane = tid & 63, wave = __builtin_amdgcn_readfirstlane(tid >> 6); (void)lane; (void)wave;
__global__ void __launch_bounds__(NTH, 2) mk_fwd(Params p) {
    extern __shared__ __attribute__((aligned(16))) unsigned char lds[];
    const int tid = threadIdx.x, lane = tid & 63, wave = __builtin_amdgcn_readfirstlane(tid >> 6);
    const int G = gridDim.x, bid = blockIdx.x;
    unsigned char* ws = p.ws;
    unsigned* ctl = (unsigned*)(ws + WS_CTL);
    LAS unsigned char* L = (LAS unsigned char*)lds;
    volatile LAS unsigned* xbw = (volatile LAS unsigned*)(L + LDS_XBW);
    if (tid < 4) xbw[tid] = 0u;
    __syncthreads();
    XcdBarrier bar = xcd_barrier_post(ctl + CW_BAR, xbw);
    float* sm = (float*)lds;
    LAS int* sbase = (LAS int*)(L + LDS_SBASE); LAS int* scnt = (LAS int*)(L + LDS_SBASE + 256); LAS int* tile_e = (LAS int*)(L + LDS_TILEE); LAS int* idxbuf = (LAS int*)(L + LDS_IDX);

    float2* tab128 = (float2*)(ws + WS_TAB128); float2* tab64 = (float2*)(ws + WS_TAB64); float2* tab8192 = (float2*)(ws + WS_TAB8192);
    bf16* memn = (bf16*)(ws + WS_MEMN); bf16* WkvT = (bf16*)(ws + WS_WKV); bf16* kmem = (bf16*)(ws + WS_KMEM); bf16* vmem = (bf16*)(ws + WS_VMEM);
    unsigned* bbase = (unsigned*)(ws + WS_BBASE);
    int* ident = (int*)(ws + WS_IDENT); float* pss = (float*)(ws + WS_PSS); float* pss2 = (float*)(ws + WS_PSS2);
    float* rsbuf = (float*)(ws + WS_RSBUF); float* slot_rs = (float*)(ws + WS_SLOTRS); bf16* RwH = (bf16*)(ws + WS_RWH); bf16* RwL = (bf16*)(ws + WS_RWL);
    int* tok_e = (int*)(ws + WS_TOKE); float* tok_g = (float*)(ws + WS_TOKG); int* tok_pos = (int*)(ws + WS_TOKPOS); int* tok_slot = (int*)(ws + WS_TOKSLOT);
    int* slot_tok = (int*)(ws + WS_SLOTTOK); float* slot_gate = (float*)(ws + WS_SLOTGATE);
    bf16* WinT = (bf16*)(ws + WS_WIN); bf16* WoutT = (bf16*)(ws + WS_WOUT); unsigned char* WguT = ws + WS_WGU; unsigned char* WdT = ws + WS_WD; unsigned char* h8 = ws + WS_H8; unsigned char* act = ws + WS_PROJ;
    bf16* hb = (bf16*)(ws + WS_HB); bf16* projb = (bf16*)(ws + WS_PROJ); bf16* Mid = (bf16*)(ws + WS_MID);
    bf16* tabC = (bf16*)(ws + WS_TABC); bf16* tabS = (bf16*)(ws + WS_TABS); bf16* tabSn = (bf16*)(ws + WS_TABSN); bf16* tab2 = (bf16*)(ws + WS_TAB2);
    bf16* ycr = (bf16*)(ws + WS_YCAT); unsigned char* Yb = ws + WS_Y; bf16* ycatn = (bf16*)(ws + WS_YCATN); bf16* Vbuf = (bf16*)(ws + WS_V);
    bf16* x1b = hb;

    {
        PHASE_IDS
        for (int i = bid * NTH + tid; i < 8192; i += G * NTH) {
            tab8192[i] = make_float2(cospif(2.0f * (float)i / 8192.0f), sinpif(2.0f * (float)i / 8192.0f));
            if (i < 128) tab128[i] = make_float2(cospif(2.0f * (float)i / 128.0f), sinpif(2.0f * (float)i / 128.0f));
            if (i < 64) tab64[i] = make_float2(cospif(2.0f * (float)i / 64.0f), sinpif(2.0f * (float)i / 64.0f));
        }
        for (int i = bid * NTH + tid; i < 32 * 1024; i += G * NTH) {
            const int e = i >> 10, k = i & 1023; const float w = p.router_w[(size_t)k * 32 + e]; const unsigned hi = f2bf(w);
            RwH[i] = (bf16)hi; RwL[i] = (bf16)f2bf(w - bf2f((bf16)hi));
        }
        for (int i = bid * NTH + tid; i < 128 * 128; i += G * NTH) {
            const int k1 = i >> 7, r = i & 127, ph = (k1 * r) & 127; const float cs = cospif(2.0f * (float)ph / 128.0f), sn = sinpif(2.0f * (float)ph / 128.0f);
            tabC[i] = (bf16)f2bf(cs); tabS[i] = (bf16)f2bf(sn); tabSn[i] = (bf16)f2bf(-sn);
            if (i < 64 * 128) { const int k2 = i >> 7, kk = i & 127, c = kk & 63, p2 = (k2 * c) & 63; tab2[i] = (bf16)f2bf(kk < 64 ? cospif(2.0f * (float)p2 / 64.0f) : sinpif(2.0f * (float)p2 / 64.0f)); }
        }
        LAS float* scr = (LAS float*)(L + wave * 17408);
        const int gw = bid * 8 + wave, NGW = G * 8;
        constexpr int I_IN = 16 * 80, I_OUT = 24 * 32, I_KV = 16 * 32;
        for (int it = gw; it < I_KV + I_IN + I_OUT; it += NGW) {
            int r = it;
            if (r < I_KV) { const int kb = r / 32, nb = r % 32; transpose_item(p.w_mem_kv, 1024, 1024, WkvT, nb * 32, kb * 64, nb * 32, scr, lane); continue; } r -= I_KV;
            if (r < I_IN) { const int kb = r / 80, nb = r % 80; transpose_item(p.w_in, INW, 1024, WinT, nb * 32, kb * 64, nb * 32, scr, lane); continue; } r -= I_IN;
            { const int kb = r / 32, nb = r % 32; transpose_item(p.w_out, 1024, MIXW, WoutT, nb * 32, kb * 64, nb * 32, scr, lane, p.g_grp); }
        }
        {
            LAS float* xscr = scr;
            constexpr int I_X2 = 16384 + 8192;
            int it = 16384 + gw; float4 ra[16], rb[16];
            XDesc da = xdesc(it < I_X2 ? it : 0, p.w_gu, p.w_down, WguT, WdT), db = da;
            if (it < I_X2) xload(da, ra, lane);
            while (it < I_X2) {
                const int nit = it + NGW;
                if (nit < I_X2) { db = xdesc(nit, p.w_gu, p.w_down, WguT, WdT); xload(db, rb, lane); }
                xstore(da, ra, 32.0f, xscr, lane);
                da = db;
#pragma unroll
                for (int i = 0; i < 16; ++i) ra[i] = rb[i];
                it = nit;
            }
        }
        for (int m = 2 * gw; m < T; m += 2 * NGW) {
            float4 va[4], vb[4]; float sa = 0.f, sb = 0.f;
#pragma unroll
            for (int j = 0; j < 4; ++j) { va[j] = ld_nt_f4(p.x + (size_t)m * D + 4 * (lane + 64 * j)); vb[j] = ld_nt_f4(p.x + (size_t)(m + 1) * D + 4 * (lane + 64 * j)); }
#pragma unroll
            for (int j = 0; j < 4; ++j) { sa += va[j].x * va[j].x + va[j].y * va[j].y + va[j].z * va[j].z + va[j].w * va[j].w; sb += vb[j].x * vb[j].x + vb[j].y * vb[j].y + vb[j].z * vb[j].z + vb[j].w * vb[j].w; }
            sa = wave_sum(sa); sb = wave_sum(sb);
            const float ra = 1.0f / sqrtf(sa * (1.0f / 1024.0f) + 1e-6f), rb = 1.0f / sqrtf(sb * (1.0f / 1024.0f) + 1e-6f);
#pragma unroll
            for (int j = 0; j < 4; ++j) { const float4 gg = ((const float4*)p.g_mix)[lane + 64 * j];
                ((uint2*)(hb + (size_t)m * D))[lane + 64 * j] = make_uint2(pkbf(va[j].x * ra * gg.x, va[j].y * ra * gg.y), pkbf(va[j].z * ra * gg.z, va[j].w * ra * gg.w));
                ((uint2*)(hb + (size_t)(m + 1) * D))[lane + 64 * j] = make_uint2(pkbf(vb[j].x * rb * gg.x, vb[j].y * rb * gg.y), pkbf(vb[j].z * rb * gg.z, vb[j].w * rb * gg.w)); }
        }
        { float4 v[4]; for (int m = gw; m < 1024; m += NGW) rms_row_bf16(p.mem + (size_t)m * D, p.g_mem, memn + (size_t)m * D, lane, v); }
    }
    xcd_barrier(bar);

    {
        PHASE_IDS
        pg8::Gemm g{hb, WinT, 1024}; pg8::GroupOrder S; S.init(T / 256, 10, 8, G, bid, nullptr, nullptr);
        pg8::EpiBf16Plain E{projb, PW};
        pg8::SideGu SD{p.w_gu, WguT, 0, 80, bid};
        pg8::gemm_phase<pg8::EpiBf16Plain, pg8::GroupOrder, false, false, pg8::SideGu>(L, idxbuf, g, S, E, SD);
        {
            const int fr = lane & 15, g4 = lane >> 4;
            for (int tile = bid * 8 + wave; tile < 2048; tile += G * 8) {
                const int rt = tile >> 5, cp = tile & 31;
                f32x4 c0 = {0.f, 0.f, 0.f, 0.f}, c1 = {0.f, 0.f, 0.f, 0.f};
                const bf16* ap = memn + (size_t)(16 * rt + fr) * 1024 + 8 * g4; const bf16* bp = WkvT + (size_t)(32 * cp + fr) * 1024 + 8 * g4;
#pragma unroll 4
                for (int kc = 0; kc < 32; ++kc) { const bf16x8 a = *(const bf16x8*)(ap + 32 * kc), b0 = *(const bf16x8*)(bp + 32 * kc), b1 = *(const bf16x8*)(bp + 16 * 1024 + 32 * kc);
                    c0 = MFMA16(a, b0, c0); c1 = MFMA16(a, b1, c1); }
#pragma unroll
                for (int nb = 0; nb < 2; ++nb) { const int n = 32 * cp + 16 * nb + fr, isv = n >> 9, hm = (n >> 7) & 3, d = n & 127; bf16* dst = isv ? vmem : kmem;
#pragma unroll
                    for (int i = 0; i < 4; ++i) { const int row = 16 * rt + 4 * g4 + i, b = row >> 8, m = row & 255;
                        dst[((size_t)((b * 4 + hm) * 256 + m)) * 128 + d] = (bf16)f2bf(nb ? c1[i] : c0[i]); } }
            }
        }
    }
    xcd_barrier(bar);

    na_attn_phase(L, projb, p.rel_bias, ycr, pss, bid, G);
    mem_attn_phase(L, projb, kmem, vmem, ycr, pss, bid, G);

    ft_stage1_phase(L, projb, Mid, tabC, tabS, tabSn, tab8192, bid, G);
    xcd_barrier(bar);

    ft_stage2_phase(L, Mid, ycr, tab2, pss2, bid, G);
    xcd_barrier(bar);

    {
        PHASE_IDS
        pg8::Gemm g{ycr, WoutT, MIXW}; pg8::GroupOrder S; S.init(T / 256, 4, 8, G, bid, nullptr, nullptr);
        LAS float* rq = (LAS float*)(L + LDS_CTRL + 4096);
        for (int idx = tid; idx < 2 * 256; idx += NTH) {
            const int i = idx >> 8, r = idx & 255; pg8::Unit u;
            if (S.next(i, u)) {
                const size_t row = (size_t)u.pm * 256 + r;
                const float4 a0 = *(const float4*)(pss + row * 12), a1 = *(const float4*)(pss + row * 12 + 4), a2 = *(const float4*)(pss + row * 12 + 8);
                const float s_na = (a0.x + a0.y) + (a0.z + a0.w) + (a1.x + a1.y) + (a1.z + a1.w), s_mem = (a2.x + a2.y) + (a2.z + a2.w), s_ft = pss2[row];
                const float r_na = 1.0f / sqrtf(s_na * (1.0f / 512.0f) + 1e-6f), r_ft = 1.0f / sqrtf(s_ft * (1.0f / 512.0f) + 1e-6f), r_mem = 1.0f / sqrtf(s_mem * (1.0f / 512.0f) + 1e-6f);
                rq[idx * 4 + 0] = r_na / r_ft; rq[idx * 4 + 1] = r_ft / r_mem; rq[idx * 4 + 2] = r_mem;
            }
        }
        __syncthreads();
        pg8::EpiResBf16 E{p.x, x1b, rq};
        pg8::SideGu SD{p.w_gu, WguT, 80, 48, bid};
        pg8::gemm_phase<pg8::EpiResBf16, pg8::GroupOrder, false, false, pg8::SideGu>(L, idxbuf, g, S, E, SD);
    }
    xcd_barrier(bar);

    {
        PHASE_IDS
        const int fr = lane & 15, g4 = lane >> 4;
        constexpr int RW_PITCH = 2064;
        {
            const u32x4_t* sh = (const u32x4_t*)RwH; const u32x4_t* sl = (const u32x4_t*)RwL;
#pragma unroll
            for (int i = 0; i < 8; ++i) { const int pc = tid + 512 * i, row = pc >> 7, ch = pc & 127;
                *(LAS u32x4_t*)(L + row * RW_PITCH + ch * 16) = sh[pc]; *(LAS u32x4_t*)(L + (32 + row) * RW_PITCH + ch * 16) = sl[pc]; }
        }
        LAS unsigned* lcnt = (LAS unsigned*)(L + 64 * RW_PITCH);
        if (tid < 32) lcnt[tid] = 0u;
        __syncthreads();
        for (int tl = bid * 8 + wave; tl < T / 16; tl += G * 8) {
            const int tok = 16 * tl + fr;
            const bf16* xr = x1b + (size_t)tok * D + 8 * g4; unsigned char* hr = h8 + (size_t)tok * D + 8 * g4;
            const float* gp = p.g_ffn + 8 * g4;
            const LAS unsigned char* w0h = L + fr * RW_PITCH + 16 * g4; const LAS unsigned char* w1h = w0h + 16 * RW_PITCH; const LAS unsigned char* w0l = w0h + 32 * RW_PITCH; const LAS unsigned char* w1l = w0h + 48 * RW_PITCH;
            f32x4 acc0 = {0.f, 0.f, 0.f, 0.f}, acc1 = {0.f, 0.f, 0.f, 0.f}; float ssq = 0.f;
#pragma unroll 8
            for (int kc = 0; kc < 32; ++kc) {
                const u32x4_t xw = __builtin_nontemporal_load((const u32x4_t*)(xr + 32 * kc));
                const float4 a = make_float4(__builtin_bit_cast(float, xw.x << 16), __builtin_bit_cast(float, xw.x & 0xffff0000u), __builtin_bit_cast(float, xw.y << 16), __builtin_bit_cast(float, xw.y & 0xffff0000u));
                const float4 b = make_float4(__builtin_bit_cast(float, xw.z << 16), __builtin_bit_cast(float, xw.z & 0xffff0000u), __builtin_bit_cast(float, xw.w << 16), __builtin_bit_cast(float, xw.w & 0xffff0000u));
                const float4 ga = *(const float4*)(gp + 32 * kc), gb = *(const float4*)(gp + 32 * kc + 4);
                ssq += (a.x * a.x + a.y * a.y) + (a.z * a.z + a.w * a.w) + (b.x * b.x + b.y * b.y) + (b.z * b.z + b.w * b.w);
                const float h0 = a.x * ga.x, h1 = a.y * ga.y, h2v = a.z * ga.z, h3 = a.w * ga.w, h4 = b.x * gb.x, h5 = b.y * gb.y, h6 = b.z * gb.z, h7 = b.w * gb.w;
                u32x4_t hi; hi.x = pkbf(h0, h1); hi.y = pkbf(h2v, h3); hi.z = pkbf(h4, h5); hi.w = pkbf(h6, h7);
                u32x4_t lo;
                lo.x = pkbf(h0 - __builtin_bit_cast(float, hi.x << 16), h1 - __builtin_bit_cast(float, hi.x & 0xffff0000u));
                lo.y = pkbf(h2v - __builtin_bit_cast(float, hi.y << 16), h3 - __builtin_bit_cast(float, hi.y & 0xffff0000u));
                lo.z = pkbf(h4 - __builtin_bit_cast(float, hi.z << 16), h5 - __builtin_bit_cast(float, hi.z & 0xffff0000u));
                lo.w = pkbf(h6 - __builtin_bit_cast(float, hi.w << 16), h7 - __builtin_bit_cast(float, hi.w & 0xffff0000u));
                *(uint2*)(hr + 32 * kc) = make_uint2(pk_fp8x4(h0, h1, h2v, h3), pk_fp8x4(h4, h5, h6, h7));
                const bf16x8 hh = __builtin_bit_cast(bf16x8, hi), hl = __builtin_bit_cast(bf16x8, lo);
                const bf16x8 a0h = *(const LAS bf16x8*)(w0h + 64 * kc), a1h = *(const LAS bf16x8*)(w1h + 64 * kc), a0l = *(const LAS bf16x8*)(w0l + 64 * kc), a1l = *(const LAS bf16x8*)(w1l + 64 * kc);
                acc0 = MFMA16(a0h, hh, acc0); acc0 = MFMA16(a0l, hh, acc0); acc0 = MFMA16(a0h, hl, acc0);
                acc1 = MFMA16(a1h, hh, acc1); acc1 = MFMA16(a1l, hh, acc1); acc1 = MFMA16(a1h, hl, acc1);
            }
            ssq += __shfl_xor(ssq, 16); ssq += __shfl_xor(ssq, 32);
            const float rs = 1.0f / sqrtf(ssq * (1.0f / 1024.0f) + 1e-6f);
            const float4 rb0 = *(const float4*)(p.router_b + 4 * g4), rb1 = *(const float4*)(p.router_b + 16 + 4 * g4);
            float lv[8] = {acc0[0] * rs + rb0.x, acc0[1] * rs + rb0.y, acc0[2] * rs + rb0.z, acc0[3] * rs + rb0.w, acc1[0] * rs + rb1.x, acc1[1] * rs + rb1.y, acc1[2] * rs + rb1.z, acc1[3] * rs + rb1.w};
            float tv[4]; int ti[4];
#pragma unroll
            for (int k = 0; k < 4; ++k) {
                float bv = -3.0e38f; int bi = 0;
#pragma unroll
                for (int j = 0; j < 8; ++j) { const int ej = (j < 4 ? 4 * g4 + j : 16 + 4 * g4 + (j - 4)); if (lv[j] > bv) { bv = lv[j]; bi = ej; } }
#pragma unroll
                for (int o = 16; o <= 32; o <<= 1) { const float ov = __shfl_xor(bv, o); const int oi = __shfl_xor(bi, o); if (ov > bv || (ov == bv && oi < bi)) { bv = ov; bi = oi; } }
                tv[k] = bv; ti[k] = bi;
#pragma unroll
                for (int j = 0; j < 8; ++j) { const int ej = (j < 4 ? 4 * g4 + j : 16 + 4 * g4 + (j - 4)); if (ej == bi) lv[j] = -3.0e38f; }
            }
            const float e1 = expf(tv[1] - tv[0]), e2 = expf(tv[2] - tv[0]), e3 = expf(tv[3] - tv[0]);
            const float inv = 1.0f / (1.0f + e1 + e2 + e3);
            if (g4 == 0) {
                int4 ps;
                ps.x = (int)__hip_atomic_fetch_add(lcnt + ti[0], 1u, __ATOMIC_RELAXED, __HIP_MEMORY_SCOPE_WORKGROUP);
                ps.y = (int)__hip_atomic_fetch_add(lcnt + ti[1], 1u, __ATOMIC_RELAXED, __HIP_MEMORY_SCOPE_WORKGROUP);
                ps.z = (int)__hip_atomic_fetch_add(lcnt + ti[2], 1u, __ATOMIC_RELAXED, __HIP_MEMORY_SCOPE_WORKGROUP);
                ps.w = (int)__hip_atomic_fetch_add(lcnt + ti[3], 1u, __ATOMIC_RELAXED, __HIP_MEMORY_SCOPE_WORKGROUP);
                *(int4*)(tok_e + tok * 4) = make_int4(ti[0], ti[1], ti[2], ti[3]);
                *(float4*)(tok_g + tok * 4) = make_float4(inv, e1 * inv, e2 * inv, e3 * inv);
                *(int4*)(tok_pos + tok * 4) = ps;
                rsbuf[tok] = rs;
            }
        }
        __syncthreads();
        if (tid < 32) bbase[bid * 32 + tid] = atomicAdd(&ctl[CW_CNT + tid * 64], lcnt[tid]);
    }
    xcd_barrier(bar);

    {
        PHASE_IDS
        if (tid == 0) {
            int run = 0;
            for (int e = 0; e < 32; ++e) { const int c = (int)xb_ld(&ctl[CW_CNT + e * 64]); scnt[e] = c; sbase[e] = run; const int nt_e = (c + 255) / 256; for (int q = 0; q < nt_e; ++q) tile_e[run / 256 + q] = e; run += nt_e * 256; }
            sbase[32] = run;
        }
        __syncthreads();
        for (int i = bid * NTH + tid; i < MAXSLOT; i += G * NTH) ident[i] = i;
        for (int i = bid * NTH + tid; i < T * 4; i += G * NTH) {
            const int e = tok_e[i], blk = ((i >> 6) >> 3) % G, slot = sbase[e] + (int)bbase[blk * 32 + e] + tok_pos[i];
            slot_tok[slot] = i >> 2; slot_gate[slot] = tok_g[i]; slot_rs[slot] = rsbuf[i >> 2]; tok_slot[i] = slot;
        }
        if (bid < 32) { const int e = bid; for (int q = scnt[e] + tid; q < sbase[e + 1] - sbase[e]; q += NTH) { slot_tok[sbase[e] + q] = 0; slot_gate[sbase[e] + q] = 0.f; slot_rs[sbase[e] + q] = 0.f; } }
    }
    xcd_barrier(bar);

    const int ntm = sbase[32] / 256;
    {
        PHASE_IDS
        pg8::Gemm g{(const bf16*)h8, (const bf16*)WguT, 512}; pg8::GroupOrder S; S.init(ntm, 8, 4, G, bid, tile_e, slot_tok);
        pg8::EpiSwiglu E{act, p.b_gu, slot_rs, 1.0f / 32.0f};
        pg8::gemm_phase<pg8::EpiSwiglu, pg8::GroupOrder, true, true>(L, idxbuf, g, S, E);
    }
    xcd_barrier(bar);

    {
        PHASE_IDS
        pg8::Gemm g{(const bf16*)act, (const bf16*)WdT, 512}; pg8::GroupOrder S; S.init(ntm, 4, 8, G, bid, tile_e, ident); S.rev = 1;
        pg8::EpiDown E{Yb, p.b_down, slot_gate, 1.0f / 32.0f};
        pg8::gemm_phase<pg8::EpiDown, pg8::GroupOrder, true, true>(L, idxbuf, g, S, E);
    }
    xcd_barrier(bar);

    {
        PHASE_IDS
        for (int tok = bid * 8 + wave; tok < T; tok += G * 8) {
            float4 v[4]; float s = 0.f;
            const int4 sl4 = *(const int4*)(tok_slot + tok * 4);
            const int sl[4] = {sl4.x, sl4.y, sl4.z, sl4.w};
            uint2 xw[4]; unsigned yw[4][4];
#pragma unroll
            for (int j = 0; j < 4; ++j) { { const ntu2 t_ = __builtin_nontemporal_load((const ntu2*)(x1b + (size_t)tok * D) + lane + 64 * j); xw[j] = make_uint2(t_[0], t_[1]); }
#pragma unroll
                for (int q = 0; q < 4; ++q) yw[q][j] = __builtin_nontemporal_load((const unsigned*)(Yb + (size_t)sl[q] * 1024) + lane + 64 * j); }
#pragma unroll
            for (int j = 0; j < 4; ++j) {
                float ax = 0.f, ay = 0.f, az = 0.f, aw = 0.f;
#pragma unroll
                for (int q = 0; q < 4; ++q) { const f32x2_t lo = __builtin_amdgcn_cvt_pk_f32_fp8((int)yw[q][j], false), hi = __builtin_amdgcn_cvt_pk_f32_fp8((int)yw[q][j], true); ax += lo[0]; ay += lo[1]; az += hi[0]; aw += hi[1]; }
                v[j].x = __builtin_bit_cast(float, xw[j].x << 16) + ax * 0.0625f; v[j].y = __builtin_bit_cast(float, xw[j].x & 0xffff0000u) + ay * 0.0625f;
                v[j].z = __builtin_bit_cast(float, xw[j].y << 16) + az * 0.0625f; v[j].w = __builtin_bit_cast(float, xw[j].y & 0xffff0000u) + aw * 0.0625f;
                s += v[j].x * v[j].x + v[j].y * v[j].y + v[j].z * v[j].z + v[j].w * v[j].w;
            }
            s = wave_sum(s);
            const float rs = 1.0f / sqrtf(s * (1.0f / 1024.0f) + 1e-6f);
#pragma unroll
            for (int j = 0; j < 4; ++j) { const float4 gg = ((const float4*)p.g_final)[lane + 64 * j];
                v[j].x *= rs * gg.x; v[j].y *= rs * gg.y; v[j].z *= rs * gg.z; v[j].w *= rs * gg.w; __builtin_nontemporal_store((ntf4){v[j].x, v[j].y, v[j].z, v[j].w}, (ntf4*)(p.out + (size_t)tok * D) + lane + 64 * j); }
        }
    }
}

extern "C" void kernel_launch(void* const* d_in, const int* in_sizes, int n_in, void* d_out, int out_size, void* d_ws, size_t ws_size, hipStream_t stream) {
    static int grid = 0;
    if (grid == 0) {
        if (n_in != 17 || in_sizes[0] != T * D || out_size != T * D || ws_size < WS_END) { fprintf(stderr, "kernel_launch: unexpected shapes n_in %d in0 %d out %d ws %zu\n", n_in, n_in > 0 ? in_sizes[0] : -1, out_size, ws_size); grid = -1; return; }
        int dev = 0, cus = 0, per_cu = 0;
        if (hipGetDevice(&dev) != hipSuccess || hipDeviceGetAttribute(&cus, hipDeviceAttributeMultiprocessorCount, dev) != hipSuccess) { grid = -1; return; }
        if (hipFuncSetAttribute((const void*)mk_fwd, hipFuncAttributeMaxDynamicSharedMemorySize, LDS_BYTES) != hipSuccess) { fprintf(stderr, "kernel_launch: hipFuncSetAttribute failed\n"); grid = -1; return; }
        if (hipOccupancyMaxActiveBlocksPerMultiprocessor(&per_cu, (const void*)mk_fwd, NTH, LDS_BYTES) != hipSuccess || per_cu < 1) fprintf(stderr, "kernel_launch: occupancy query says %d\n", per_cu);
        (void)hipGetLastError();
        if (cus != 256) { fprintf(stderr, "kernel_launch: %d CUs (256 expected)\n", cus); grid = -1; return; }
        grid = cus;
    }
    if (grid < 0) return;
    if (hipMemsetAsync((char*)d_ws + WS_CTL, 0, CTL_ZERO_BYTES, stream) != hipSuccess) return;
    Params p{};
    p.x = (const float*)d_in[0]; p.mem = (const float*)d_in[1]; p.g_mix = (const float*)d_in[2]; p.g_mem = (const float*)d_in[3]; p.w_in = (const float*)d_in[4];
    p.w_mem_kv = (const float*)d_in[5]; p.rel_bias = (const float*)d_in[6]; p.g_grp = (const float*)d_in[7]; p.w_out = (const float*)d_in[8]; p.g_ffn = (const float*)d_in[9];
    p.router_w = (const float*)d_in[10]; p.router_b = (const float*)d_in[11]; p.w_gu = (const float*)d_in[12]; p.b_gu = (const float*)d_in[13]; p.w_down = (const float*)d_in[14];
    p.b_down = (const float*)d_in[15]; p.g_final = (const float*)d_in[16]; p.out = (float*)d_out; p.ws = (unsigned char*)d_ws;
    hipLaunchKernelGGL(mk_fwd, dim3(grid), dim3(NTH), LDS_BYTES, stream, p);
}
```

```cpp
#include <hip/hip_runtime.h>
#include <hip/hip_runtime.h>
#include <cstdio>
#include <cstdint>

#define LAS __attribute__((address_space(3)))

#define XB_TMO      128
#define XB_XCNT(j)  (256  + 64 * (j))
#define XB_XSUB(j)  (1280 + 64 * (j))
#define XB_XGEN(j)  (2304 + 64 * (j))
#define XB_TOP      3328
#define XB_TOPGEN   3392
#define XCD_BAR_WORDS 3456
#define XB_SPIN_CAP (1u << 22)

__device__ __forceinline__ unsigned xb_ld(unsigned* p)              { return __hip_atomic_load(p, __ATOMIC_RELAXED, __HIP_MEMORY_SCOPE_AGENT); }
__device__ __forceinline__ unsigned xb_add(unsigned* p, unsigned v) { return __hip_atomic_fetch_add(p, v, __ATOMIC_RELAXED, __HIP_MEMORY_SCOPE_AGENT); }
__device__ __forceinline__ unsigned xb_xcc_id() { return (unsigned)__builtin_amdgcn_s_getreg((3 << 11) | 20) & 0xFu; }
#define XB_SPIN(cond, bar) do { unsigned _sp = 0; while (cond) { __builtin_amdgcn_s_sleep(1); \
    if ((++_sp & 255u) == 0u) { if (xb_ld(&(bar)[XB_TMO])) break; if (_sp > XB_SPIN_CAP) { atomicAdd(&(bar)[XB_TMO], 1u); break; } } } } while (0)

struct XcdBarrier { unsigned* bar; unsigned x; volatile LAS unsigned* st; };

__device__ __forceinline__ XcdBarrier xcd_barrier_post(unsigned* bar, volatile LAS unsigned* st) {
    XcdBarrier b; b.bar = bar; b.x = xb_xcc_id(); b.st = st;
    if (threadIdx.x == 0) (void)xb_add(&bar[XB_XCNT(b.x)], 1u);
    return b;
}
__device__ __forceinline__ void xcd_barrier_complete(unsigned* bar, unsigned x, unsigned& nloc, unsigned& nx) {
    const unsigned G = gridDim.x * gridDim.y * gridDim.z;
    unsigned sum, cnt, mine, sp = 0u;
    for (;;) {
        sum = 0u; cnt = 0u; mine = 0u;
#pragma unroll
        for (unsigned j = 0; j < 16; ++j) { const unsigned c = xb_ld(&bar[XB_XCNT(j)]); sum += c; cnt += (c > 0u) ? 1u : 0u; mine = (j == x) ? c : mine; }
        if (sum == G) break;
        __builtin_amdgcn_s_sleep(1);
        if ((++sp & 255u) == 0u) { if (xb_ld(&bar[XB_TMO])) break; if (sp > XB_SPIN_CAP) { atomicAdd(&bar[XB_TMO], 1u); break; } }
    }
    nloc = mine > 0u ? mine : 1u; nx = cnt > 0u ? cnt : 1u;
}
__device__ __forceinline__ void xcd_barrier(const XcdBarrier& b) {
    asm volatile("s_waitcnt vmcnt(0)" ::: "memory");
    __syncthreads();
    if (threadIdx.x == 0) {
        unsigned* bar = b.bar;
        __builtin_amdgcn_s_waitcnt(0);
        unsigned nloc = b.st[0], nx = b.st[1];
        if (nloc == 0u) { xcd_barrier_complete(bar, b.x, nloc, nx); b.st[0] = nloc; b.st[1] = nx; }
        const unsigned old = xb_add(&bar[XB_XSUB(b.x)], 1u);
        const unsigned gen = old / nloc;
        if (old + 1u == (gen + 1u) * nloc) {
            __builtin_amdgcn_fence(__ATOMIC_RELEASE, "agent");
            asm volatile("s_waitcnt vmcnt(0)" ::: "memory");
            const unsigned og = xb_add(&bar[XB_TOP], 1u);
            const unsigned tg = og / nx;
            if (og + 1u == (tg + 1u) * nx) xb_add(&bar[XB_TOPGEN], 1u);
            else XB_SPIN(xb_ld(&bar[XB_TOPGEN]) == tg, bar);
            __builtin_amdgcn_fence(__ATOMIC_ACQUIRE, "agent");
            xb_add(&bar[XB_XGEN(b.x)], 1u);
            asm volatile("s_waitcnt vmcnt(0)" ::: "memory");
        } else {
            XB_SPIN(xb_ld(&bar[XB_XGEN(b.x)]) == gen, bar);
            __builtin_amdgcn_fence(__ATOMIC_ACQUIRE, "agent");
            asm volatile("s_waitcnt vmcnt(0)" ::: "memory");
        }
    }
    __syncthreads();
}

constexpr int T = 32768, D = 1024, SEQ = 8192, INW = 2560, MIXW = 1536, NE = 32;
constexpr int NTH = 512;
constexpr int LDS_BYTES = 163840;
constexpr int MAXSLOT = 131072 + 32 * 256;
constexpr int LDS_CTRL = 151552;
constexpr int LDS_XBW = LDS_CTRL;
constexpr int LDS_SBASE = LDS_CTRL + 64;
constexpr int LDS_TILEE = LDS_CTRL + 512;
constexpr int LDS_IDX = LDS_CTRL + 4096;

constexpr size_t MiB = 1u << 20;
constexpr size_t WS_CTL = 0, CTL_ZERO_BYTES = 32 * 1024;
constexpr int CW_CNT = 0, CW_BAR = 4096;
constexpr size_t WS_TAB128 = 1 * MiB, WS_TAB64 = WS_TAB128 + 4096, WS_TAB8192 = WS_TAB128 + 8192;
constexpr size_t WS_MEMN = 2 * MiB;
constexpr size_t WS_WKV = 4 * MiB;
constexpr size_t WS_KMEM = 6 * MiB, WS_VMEM = 7 * MiB;
constexpr size_t WS_TOKE = 10 * MiB, WS_TOKG = WS_TOKE + 512 * 1024, WS_TOKPOS = 11 * MiB, WS_TOKSLOT = WS_TOKPOS + 512 * 1024;
constexpr size_t WS_SLOTTOK = 12 * MiB, WS_SLOTGATE = 13 * MiB;
constexpr size_t WS_TABC = 1 * MiB + 128 * 1024, WS_TABS = WS_TABC + 32 * 1024, WS_TABSN = WS_TABS + 32 * 1024, WS_TAB2 = WS_TABSN + 32 * 1024;
constexpr size_t WS_RWH = 1 * MiB + 256 * 1024, WS_RWL = WS_RWH + 64 * 1024;
constexpr size_t WS_PSS = 18 * MiB;
constexpr size_t WS_PSS2 = 20 * MiB;
constexpr size_t WS_IDENT = 16 * MiB;
constexpr size_t WS_BBASE = 14 * MiB, WS_RSBUF = 14 * MiB + 64 * 1024, WS_SLOTRS = 15 * MiB;
constexpr size_t WS_WIN = 32 * MiB;
constexpr size_t WS_WOUT = 40 * MiB;
constexpr size_t WS_WGU = 48 * MiB;
constexpr size_t WS_WD = 176 * MiB;
constexpr size_t WS_H8 = 208 * MiB;
constexpr size_t WS_HB = 240 * MiB;
constexpr size_t WS_PROJ = 304 * MiB;
constexpr size_t WS_V = 432 * MiB;
constexpr size_t WS_MID = 496 * MiB;
constexpr size_t WS_YCAT = 560 * MiB;
constexpr size_t WS_Y = 576 * MiB;
constexpr size_t WS_YCATN = 656 * MiB;
constexpr size_t WS_END = 848 * MiB;
constexpr int PW = 2560;

struct Params {
    const float *x, *mem, *g_mix, *g_mem, *w_in, *w_mem_kv, *rel_bias, *g_grp, *w_out, *g_ffn, *router_w, *router_b, *w_gu, *b_gu, *w_down, *b_down, *g_final;
    float* out; unsigned char* ws;
};

typedef unsigned short bf16;
typedef float ntf4 __attribute__((ext_vector_type(4)));
typedef unsigned ntu4 __attribute__((ext_vector_type(4)));
typedef unsigned ntu2 __attribute__((ext_vector_type(2)));
__device__ __forceinline__ float4 ld_nt_f4(const float* p) { const ntf4 t = __builtin_nontemporal_load((const ntf4*)p); return make_float4(t[0], t[1], t[2], t[3]); }
__device__ __forceinline__ unsigned f2bf(float f) { unsigned u = __builtin_bit_cast(unsigned, f); return (u + 0x7fffu + ((u >> 16) & 1u)) >> 16; }
__device__ __forceinline__ unsigned pk2(float lo, float hi) { return f2bf(lo) | (f2bf(hi) << 16); }
typedef float f32x2_t __attribute__((ext_vector_type(2)));
typedef __bf16 bf16x2_t __attribute__((ext_vector_type(2)));
__device__ __forceinline__ unsigned pkbf(float a, float b) { f32x2_t v = {a, b}; bf16x2_t r = __builtin_convertvector(v, bf16x2_t); return __builtin_bit_cast(unsigned, r); }
__device__ __forceinline__ float bf2f(bf16 b) { return __builtin_bit_cast(float, ((unsigned)b) << 16); }
__device__ __forceinline__ float wave_sum(float v) {
#pragma unroll
    for (int o = 1; o < 64; o <<= 1) v += __shfl_xor(v, o);
    return v;
}
__device__ __forceinline__ float wave_max(float v) {
#pragma unroll
    for (int o = 1; o < 64; o <<= 1) v = fmaxf(v, __shfl_xor(v, o));
    return v;
}

namespace pg8 {
#define PG8_LAS __attribute__((address_space(3)))
typedef unsigned short bf16_t;
typedef short bf16x8 __attribute__((ext_vector_type(8)));
typedef float f32x4 __attribute__((ext_vector_type(4)));
typedef unsigned u32x4 __attribute__((ext_vector_type(4)));
typedef unsigned u32x2 __attribute__((ext_vector_type(2)));
constexpr int BM = 256, BK = 64, HALF = 128, HTB = HALF * BK * 2, STAGE_BYTES = 8 * HTB;

__host__ __device__ __forceinline__ int lds_byte(int r, int c) { const int st = (r >> 4) * 2 + (c >> 5), rr = r & 15, cc = c & 31, ob = rr * 64 + cc * 2; return st * 1024 + (ob ^ (((ob >> 9) & 1) << 5)); }
__host__ __device__ __forceinline__ void stage_rc(int b, int& R, int& C) { const int st = b / 1024, sb = b % 1024, swz = sb ^ (((sb >> 9) & 1) << 5); R = (st >> 1) * 16 + swz / 64; C = (st & 1) * 32 + (swz % 64) / 2; }
__host__ __device__ __forceinline__ int perm32(int rho) { const int n = rho >> 4, i = rho & 15; return 8 * (i >> 2) + 4 * n + (i & 3); }

struct Unit { int pm, pn, e, pl; };
struct Gemm { const bf16_t* A; const bf16_t* Bt; int K; };

typedef int i32x4 __attribute__((ext_vector_type(4)));
typedef int i32x8 __attribute__((ext_vector_type(8)));
__device__ __forceinline__ i32x8 cat8(const bf16x8 lo, const bf16x8 hi) { return __builtin_shufflevector(__builtin_bit_cast(i32x4, lo), __builtin_bit_cast(i32x4, hi), 0, 1, 2, 3, 4, 5, 6, 7); }
__device__ __forceinline__ unsigned cvt_pk_bf16(float lo, float hi) { unsigned r; asm volatile("v_cvt_pk_bf16_f32 %0, %1, %2" : "=v"(r) : "v"(lo), "v"(hi)); return r; }

struct GroupOrder {
    int ntm, nN, nunits, Q, xcd, j, W, RG, rev; const PG8_LAS int* tile_e; const int* rowidx;
    __device__ void init(int ntm_, int nN_, int RG_, int G, int c, const PG8_LAS int* te, const int* ri) {
        ntm = ntm_; nN = nN_; RG = RG_; nunits = ntm * nN; tile_e = te; rowidx = ri; rev = 0;
        if (G % 8 == 0) { xcd = c % 8; j = c / 8; W = G / 8; Q = (nunits + 7) / 8; } else { xcd = 0; j = c; W = G; Q = nunits; }
    }
    __device__ __forceinline__ bool next(int i, Unit& u) const {
        const int ii = i * W + j; if (ii >= Q) return false;
        int idx = xcd * Q + ii; if (idx >= nunits) return false;
        if (rev) { const int hi = (xcd * Q + Q < nunits ? xcd * Q + Q : nunits) - 1; idx = hi - ii; }
        const int nig = RG * nN, gid = idx / nig, fm = gid * RG, gsz = (ntm - fm) < RG ? (ntm - fm) : RG, rem = idx - gid * nig;
        u.pm = fm + rem % gsz; u.pl = rem / gsz; u.e = tile_e ? tile_e[u.pm] : 0; u.pn = u.e * nN + u.pl; return true;
    }
    __device__ __forceinline__ void a_ready(const Unit&) const {}
    __device__ __forceinline__ void done(const Unit&) const {}
};

__device__ __forceinline__ unsigned pk_fp8x4(float a, float b, float c, float d) { int r = 0; r = __builtin_amdgcn_cvt_pk_fp8_f32(a, b, r, false); r = __builtin_amdgcn_cvt_pk_fp8_f32(c, d, r, true); return (unsigned)r; }
struct NoSide { static constexpr bool ON = false; };
struct SideGu { static constexpr bool ON = true; const float* W; unsigned char* WT; int first, count, bid; };
constexpr int SIDE_LDS = 131072, SIDE_WPITCH = 1040, SIDE_BUF = 8 * SIDE_WPITCH;
template <bool F8> struct FragSel { typedef bf16x8 type; };
template <> struct FragSel<true> { typedef i32x8 type; };
template <class Epi, class Sched, bool GATHER, bool FP8 = false, class Side = NoSide>
__device__ __forceinline__ void gemm_phase(PG8_LAS unsigned char* lds, PG8_LAS int* idxbuf, const Gemm g, const Sched& S, const Epi& E, const Side SD = Side()) {
    int tid = threadIdx.x; asm volatile("" : "+v"(tid));
    const int wid = __builtin_amdgcn_readfirstlane(tid >> 6), lane = tid & 63, wr = wid >> 2, wc = wid & 3, fr = lane & 15, fq = lane >> 4;
    const int K = g.K, nt = K / BK;
    unsigned voffB[2];
#pragma unroll
    for (int i = 0; i < 2; ++i) { int R, C; stage_rc(tid * 16 + i * 8192, R, C); const int Rb = Epi::PERM ? ((R & ~31) + perm32(R & 31)) : R;
        voffB[i] = (unsigned)(Rb * K + C) * 2u; }
    const size_t kstep = (size_t)(BK * 2);
    const size_t hstep = (size_t)HALF * K * 2;
    const size_t tstep = 2 * hstep;
    const unsigned ldsw = (unsigned)wid * 1024u;
    const int aoff = lds_byte(wr * 64 + fr, fq * 8), boff = lds_byte(wc * 32 + fr, fq * 8);
    const PG8_LAS unsigned char* ldsA = lds + aoff; const PG8_LAS unsigned char* ldsB = lds + 4 * HTB + boff;
    asm volatile("" : "+v"(ldsA), "+v"(ldsB));
#define PG8_SA(b, h) (((b) * 2 + (h)) * HTB)
#define PG8_SB(b, h) ((4 + (b) * 2 + (h)) * HTB)
#define PG8_STAGE(bufoff, gbase, voff) do { _Pragma("unroll") for (int _i = 0; _i < 2; ++_i) \
        __builtin_amdgcn_global_load_lds((const unsigned*)((const char*)(gbase) + (voff)[_i]), (PG8_LAS unsigned*)(lds + (bufoff) + ldsw + _i * 8192), 16, 0, 0); } while (0)
#define PG8_LDF(dst, base, off) do { if constexpr (FP8) { const i32x4 _lo = *(const PG8_LAS i32x4*)((base) + (off)), _hi = *(const PG8_LAS i32x4*)((base) + (off) + 1024); dst[0] = __builtin_shufflevector(_lo, _hi, 0, 1, 2, 3, 4, 5, 6, 7); } \
        else { _Pragma("unroll") for (int k = 0; k < 2; ++k) dst[k] = *(const PG8_LAS FragT*)((base) + (off) + k * 1024); } } while (0)
#define PG8_LDA(dst, b, h) do { _Pragma("unroll") for (int m = 0; m < 4; ++m) PG8_LDF(dst[m], ldsA, ((b) * 2 + (h)) * HTB + m * 2048); } while (0)
#define PG8_LDB(dst, b, h) do { _Pragma("unroll") for (int n = 0; n < 2; ++n) PG8_LDF(dst[n], ldsB, ((b) * 2 + (h)) * HTB + n * 2048); } while (0)
#define PG8_MMA(ai, bj, At, Bt) do { __builtin_amdgcn_s_setprio(1); _Pragma("unroll") for (int m = 0; m < 4; ++m) _Pragma("unroll") for (int n = 0; n < 2; ++n) { \
        if constexpr (FP8) acc[ai][bj][m][n] = __builtin_amdgcn_mfma_scale_f32_16x16x128_f8f6f4(Bt[n][0], At[m][0], acc[ai][bj][m][n], 0, 0, 0, 0, 0, 0); \
        else { _Pragma("unroll") for (int k = 0; k < 2; ++k) acc[ai][bj][m][n] = __builtin_amdgcn_mfma_f32_16x16x32_bf16(Bt[n][k], At[m][k], acc[ai][bj][m][n], 0, 0, 0); } } \
        __builtin_amdgcn_s_setprio(0); } while (0)
#define PG8_WAIT_VKR(rx) do { if (rx) asm volatile("s_waitcnt vmcnt(%0)" :: "n"((Side::ON ? 10 : 8) + Epi::NST) : "memory"); else PG8_WAIT_VK; } while (0)
#define PG8_WAIT_VK do { if constexpr (Side::ON) asm volatile("s_waitcnt vmcnt(10)" ::: "memory"); else asm volatile("s_waitcnt vmcnt(8)" ::: "memory"); } while (0)
#define PG8_SIDE_J(j) const int _J = SD.first + ((j) < SD.count ? (j) : SD.count - 1);
#define PG8_SIDE_DMA(j, par) do { if constexpr (Side::ON) { PG8_SIDE_J(j) \
        __builtin_amdgcn_global_load_lds((const unsigned*)(sd_src0 + ((size_t)_J << 21) + sd_lsrc), (PG8_LAS unsigned*)(lds + SIDE_LDS + (par) * SIDE_BUF + wid * SIDE_WPITCH), 16, 0, 2); } } while (0)
#define PG8_SIDE_RD(par) do { if constexpr (Side::ON) { const PG8_LAS unsigned char* _b = lds + SIDE_LDS + (par) * SIDE_BUF + sd_lrd; _Pragma("unroll") for (int _q = 0; _q < 4; ++_q) sdv[_q] = *(const PG8_LAS float*)(_b + _q * 128); } } while (0)
#define PG8_SIDE_ST(j) do { if constexpr (Side::ON) { PG8_SIDE_J(j) PG8_WAIT_L(0); \
        *(unsigned*)(sd_dst0 + ((size_t)(_J >> 2) << 21) + (_J & 3) * 256 + sd_ldst) = pk_fp8x4(sdv[0] * 32.0f, sdv[1] * 32.0f, sdv[2] * 32.0f, sdv[3] * 32.0f); } } while (0)
#define PG8_WAIT_V(n) asm volatile("s_waitcnt vmcnt(" #n ")" ::: "memory")
#define PG8_WAIT_L(n) asm volatile("s_waitcnt lgkmcnt(" #n ")" ::: "memory")
#define PG8_BAR __builtin_amdgcn_s_barrier()
#define PG8_SCHED __builtin_amdgcn_sched_barrier(0)
#define PG8_SETV(v, par) do { _Pragma("unroll") for (int _i = 0; _i < 2; ++_i) { int _R, _C; stage_rc(tid * 16 + _i * 8192, _R, _C); _Pragma("unroll") for (int _h = 0; _h < 2; ++_h) { \
        if constexpr (GATHER) v[_h][_i] = (unsigned)idxbuf[(par) * 256 + _h * 128 + _R] * (unsigned)(K * 2) + (unsigned)_C * 2u; \
        else v[_h][_i] = (unsigned)((_h * 128 + _R) * K) * 2u + (unsigned)_C * 2u; } } } while (0)
#define PG8_AUXDMA(u, par) do { if constexpr (Epi::AUX) { PG8_LAS float* _ax = (PG8_LAS float*)(idxbuf + 512) + (par) * 512; \
        if (wid >= 4) __builtin_amdgcn_global_load_lds((const unsigned*)(E.rowsrc(u) + (wid - 4) * 64 + lane), (PG8_LAS unsigned*)(_ax + (wid - 4) * 64), 4, 0, 0); \
        else __builtin_amdgcn_global_load_lds((const unsigned*)(E.colsrc(u, wid) + lane), (PG8_LAS unsigned*)(_ax + 256 + wid * 64), 4, 0, 0); } } while (0)
#define PG8_IDXDMA(u, par) do { if constexpr (GATHER) { if (wid < 4) \
        __builtin_amdgcn_global_load_lds((const unsigned*)(S.rowidx + (size_t)(u).pm * 256 + wid * 64 + lane), (PG8_LAS unsigned*)(idxbuf + (par) * 256 + wid * 64), 4, 0, 0); } } while (0)
    Unit cur, nxt; int ui = 0;
    if (!S.next(0, cur)) return;
    int sj = 0; float sdv[4];
    const unsigned sd_lsrc = (unsigned)((lane >> 3) * 8192 + (lane & 7) * 16), sd_lrd = (unsigned)(((lane & 15) >> 1) * SIDE_WPITCH + (lane & 1) * 512 + (4 * wid + (lane >> 4)) * 4), sd_ldst = (unsigned)((lane >> 4) * 1024 + 4 * (lane & 15));
    const char* sd_src0 = nullptr; unsigned char* sd_dst0 = nullptr;
    if constexpr (Side::ON) { const int nb = SD.bid & 63, kq = SD.bid >> 6;
        sd_src0 = (const char*)SD.W + (size_t)((kq * 64 + wid * 8) * 8192 + nb * 128);
        sd_dst0 = SD.WT + (size_t)((((nb >> 2) & 7) * 256 + (nb >> 5) * 128 + (nb & 3) * 32 + 4 * wid) * 1024 + kq * 64); }
    PG8_SIDE_DMA(0, 0);
    f32x4 acc[2][2][4][2];
#pragma unroll
    for (int a = 0; a < 2; ++a)
#pragma unroll
        for (int b = 0; b < 2; ++b)
#pragma unroll
            for (int m = 0; m < 4; ++m)
#pragma unroll
                for (int n = 0; n < 2; ++n) acc[a][b][m][n] = (f32x4){0.f, 0.f, 0.f, 0.f};
    typedef typename FragSel<FP8>::type FragT; constexpr int KF = FP8 ? 1 : 2;
    FragT At[4][KF], B0[2][KF], B1[2][KF];
    const char* cA = GATHER ? (const char*)g.A : (const char*)g.A + (size_t)cur.pm * tstep; const char* cB = (const char*)g.Bt + (size_t)cur.pn * tstep;
    unsigned cv[2][2], nv[2][2];
    if constexpr (GATHER) { PG8_IDXDMA(cur, 0); PG8_WAIT_V(0); PG8_BAR; }
    PG8_SETV(cv, 0);
    S.a_ready(cur);
    PG8_STAGE(PG8_SB(0, 0), cB, voffB); PG8_STAGE(PG8_SB(0, 1), cB + hstep, voffB); PG8_STAGE(PG8_SA(0, 0), cA, cv[0]); PG8_STAGE(PG8_SA(0, 1), cA, cv[1]);
    if (wr == 1) PG8_BAR;
    PG8_WAIT_V(2); PG8_BAR;
    PG8_STAGE(PG8_SB(1, 0), cB + kstep, voffB); PG8_STAGE(PG8_SA(1, 0), cA + kstep, cv[0]); PG8_STAGE(PG8_SB(1, 1), cB + hstep + kstep, voffB);
    PG8_WAIT_V(6); PG8_BAR;
    for (;;) {
        const bool has_next = S.next(ui + 1, nxt);
        const char* nA = has_next ? (GATHER ? (const char*)g.A : (const char*)g.A + (size_t)nxt.pm * tstep) : cA; const char* nB = has_next ? (const char*)g.Bt + (size_t)nxt.pn * tstep : cB;
        if (has_next) PG8_IDXDMA(nxt, (ui + 1) & 1);
#pragma unroll
        for (int h = 0; h < 2; ++h)
#pragma unroll
            for (int i = 0; i < 2; ++i) nv[h][i] = cv[h][i];
#pragma unroll 1
        for (int t = 0; t < nt; t += 2) {
            const bool last = (t == nt - 2), relax = (t == 0) && (ui > 0) && (Epi::NST > 0);
            const char* a1 = cA + (size_t)(t + 1) * kstep;
            const char* a2 = last ? nA : cA + (size_t)(t + 2) * kstep; const char* b2 = last ? nB : cB + (size_t)(t + 2) * kstep;
            const char* a3 = a2 + kstep; const char* b3 = b2 + kstep;
            if (last && has_next) { S.a_ready(nxt); PG8_SETV(nv, (ui + 1) & 1); }
            if constexpr (Epi::KSCALE) { if (t == 8 || t == 16) E.kscale(acc, ui, t == 8 ? 0 : 1, wr, fr); }
            if (t == 2) PG8_AUXDMA(cur, ui & 1);
            PG8_SIDE_DMA(sj + 1, 1); PG8_LDB(B0, 0, 0); PG8_LDB(B1, 0, 1); PG8_SCHED; PG8_LDA(At, 0, 0); PG8_STAGE(PG8_SA(1, 1), a1, cv[1]);
            if (last) {
#pragma unroll
                for (int h = 0; h < 2; ++h)
#pragma unroll
                    for (int i = 0; i < 2; ++i) cv[h][i] = nv[h][i]; }
            PG8_WAIT_VKR(relax); PG8_WAIT_L(0); PG8_BAR; PG8_MMA(0, 0, At, B0); PG8_MMA(0, 1, At, B1); PG8_BAR; PG8_SCHED;
            PG8_LDA(At, 0, 1); PG8_SIDE_RD(0); PG8_STAGE(PG8_SB(0, 0), b2, voffB); PG8_STAGE(PG8_SB(0, 1), b2 + hstep, voffB); PG8_STAGE(PG8_SA(0, 0), a2, cv[0]); PG8_SIDE_ST(sj);
            PG8_WAIT_VKR(relax); PG8_WAIT_L(0); PG8_BAR; PG8_MMA(1, 0, At, B0); PG8_MMA(1, 1, At, B1); PG8_BAR; PG8_SCHED;
            PG8_SIDE_DMA(sj + 2, 0); PG8_LDB(B0, 1, 0); PG8_LDB(B1, 1, 1); PG8_SCHED; PG8_LDA(At, 1, 0); PG8_STAGE(PG8_SA(0, 1), a2, cv[1]);
            PG8_WAIT_VK; PG8_WAIT_L(0); PG8_BAR; PG8_MMA(0, 0, At, B0); PG8_MMA(0, 1, At, B1); PG8_BAR; PG8_SCHED;
            PG8_LDA(At, 1, 1); PG8_SIDE_RD(1); PG8_STAGE(PG8_SB(1, 0), b3, voffB); PG8_STAGE(PG8_SB(1, 1), b3 + hstep, voffB); PG8_STAGE(PG8_SA(1, 0), a3, cv[0]); PG8_SIDE_ST(sj + 1);
            PG8_WAIT_VK; PG8_WAIT_L(0); PG8_BAR; PG8_MMA(1, 0, At, B0); PG8_MMA(1, 1, At, B1); PG8_BAR; PG8_SCHED;
            sj += 2;
        }
        if (wr == 0) PG8_BAR;
        E(acc, cur, wr, wc, fr, fq, (const PG8_LAS float*)(idxbuf + 512) + (ui & 1) * 512, ui); S.done(cur);
        if (!has_next) break;
#pragma unroll
        for (int a = 0; a < 2; ++a)
#pragma unroll
            for (int b = 0; b < 2; ++b)
#pragma unroll
                for (int m = 0; m < 4; ++m)
#pragma unroll
                    for (int n = 0; n < 2; ++n) acc[a][b][m][n] = (f32x4){0.f, 0.f, 0.f, 0.f};
        cur = nxt; cA = nA; cB = nB; ++ui;
        if (wr == 1) PG8_BAR;
    }
    PG8_WAIT_V(0);
    PG8_BAR;
#undef PG8_SA
#undef PG8_WAIT_VK
#undef PG8_WAIT_VKR
#undef PG8_SIDE_J
#undef PG8_SIDE_DMA
#undef PG8_SIDE_RD
#undef PG8_SIDE_ST
#undef PG8_SB
#undef PG8_STAGE
#undef PG8_LDA
#undef PG8_LDF
#undef PG8_LDB
#undef PG8_MMA
#undef PG8_WAIT_V
#undef PG8_WAIT_L
#undef PG8_BAR
#undef PG8_SCHED
#undef PG8_SETV
#undef PG8_IDXDMA
#undef PG8_AUXDMA
}

struct EpiBf16Plain {
    static constexpr bool PERM = true, AUX = false, KSCALE = false; static constexpr int NST = 16;
    bf16_t* O; int ldc;
    __device__ __forceinline__ void operator()(const f32x4 (&acc)[2][2][4][2], const Unit& u, int wr, int wc, int fr, int fq, const PG8_LAS float* aux, int ui) const {
        const int row0 = u.pm * BM + wr * 64 + fr, col0 = u.pl * BM + wc * 32 + 8 * fq;
#pragma unroll
        for (int ai = 0; ai < 2; ++ai)
#pragma unroll
            for (int m = 0; m < 4; ++m) { bf16_t* rowp = O + (size_t)(row0 + ai * HALF + m * 16) * ldc + col0;
#pragma unroll
                for (int bj = 0; bj < 2; ++bj) { const f32x4 v0 = acc[ai][bj][m][0], v1 = acc[ai][bj][m][1];
                    u32x4 w; w.x = cvt_pk_bf16(v0[0], v0[1]); w.y = cvt_pk_bf16(v0[2], v0[3]); w.z = cvt_pk_bf16(v1[0], v1[1]); w.w = cvt_pk_bf16(v1[2], v1[3]);
                    *(u32x4*)(rowp + bj * HALF) = w; } }
    }
};
struct EpiProj3 {
    static constexpr bool PERM = true, AUX = false, KSCALE = false; static constexpr int NST = 0;
    bf16_t* P; bf16_t* V;
    __device__ __forceinline__ void operator()(const f32x4 (&acc)[2][2][4][2], const Unit& u, int wr, int wc, int fr, int fq, const PG8_LAS float* aux, int ui) const {
        const bool isv = (u.pl >= 6) && (u.pl < 10);
        bf16_t* O = isv ? V : P; const int ldc = isv ? 1024 : 2048;
        const int colt = u.pl < 6 ? u.pl * BM : (isv ? (u.pl - 6) * BM : 1536 + (u.pl - 10) * BM);
        const int row0 = u.pm * BM + wr * 64 + fr, col0 = colt + wc * 32 + 8 * fq;
#pragma unroll
        for (int ai = 0; ai < 2; ++ai)
#pragma unroll
            for (int m = 0; m < 4; ++m) { bf16_t* rowp = O + (size_t)(row0 + ai * HALF + m * 16) * ldc + col0;
#pragma unroll
                for (int bj = 0; bj < 2; ++bj) { const f32x4 v0 = acc[ai][bj][m][0], v1 = acc[ai][bj][m][1];
                    u32x4 w; w.x = cvt_pk_bf16(v0[0], v0[1]); w.y = cvt_pk_bf16(v0[2], v0[3]); w.z = cvt_pk_bf16(v1[0], v1[1]); w.w = cvt_pk_bf16(v1[2], v1[3]);
                    *(u32x4*)(rowp + bj * HALF) = w; } }
    }
};
struct EpiResBf16 {
    static constexpr bool PERM = true, AUX = false, KSCALE = true; static constexpr int NST = 16;
    const float* base; bf16_t* C; const PG8_LAS float* rq;
    __device__ __forceinline__ void kscale(f32x4 (&acc)[2][2][4][2], int ui, int which, int wr, int fr) const {
#pragma unroll
        for (int ai = 0; ai < 2; ++ai)
#pragma unroll
            for (int m = 0; m < 4; ++m) { const float q = rq[(ui * 256 + ai * HALF + wr * 64 + m * 16 + fr) * 4 + which];
#pragma unroll
                for (int bj = 0; bj < 2; ++bj)
#pragma unroll
                    for (int n = 0; n < 2; ++n) acc[ai][bj][m][n] = acc[ai][bj][m][n] * q; }
    }
    __device__ __forceinline__ void operator()(const f32x4 (&acc)[2][2][4][2], const Unit& u, int wr, int wc, int fr, int fq, const PG8_LAS float* aux, int ui) const {
        const int row0 = u.pm * BM + wr * 64 + fr, col0 = u.pl * BM + wc * 32 + 8 * fq;
#pragma unroll
        for (int ai = 0; ai < 2; ++ai)
#pragma unroll
            for (int m = 0; m < 4; ++m) { const size_t off = (size_t)(row0 + ai * HALF + m * 16) * 1024 + col0; const float q3 = rq[(ui * 256 + ai * HALF + wr * 64 + m * 16 + fr) * 4 + 2];
#pragma unroll
                for (int bj = 0; bj < 2; ++bj) { const f32x4 b0 = __builtin_nontemporal_load((const f32x4*)(base + off + bj * HALF)), b1 = __builtin_nontemporal_load((const f32x4*)(base + off + bj * HALF + 4));
                    const f32x4 v0 = b0 + acc[ai][bj][m][0] * q3, v1 = b1 + acc[ai][bj][m][1] * q3;
                    u32x4 w; w.x = cvt_pk_bf16(v0[0], v0[1]); w.y = cvt_pk_bf16(v0[2], v0[3]); w.z = cvt_pk_bf16(v1[0], v1[1]); w.w = cvt_pk_bf16(v1[2], v1[3]);
                    *(u32x4*)(C + off + bj * HALF) = w; }
                if (m & 1) asm volatile("" ::: "memory"); }
    }
};
typedef float f32x2 __attribute__((ext_vector_type(2)));
__device__ __forceinline__ f32x2 swiglu2(f32x2 g, f32x2 l) {
    g = __builtin_elementwise_min(g, (f32x2){7.0f, 7.0f});
    l = __builtin_elementwise_min(__builtin_elementwise_max(l, (f32x2){-7.0f, -7.0f}), (f32x2){7.0f, 7.0f});
    const f32x2 z = g * (-1.702f * 1.4426950408889634f);
    f32x2 t; t.x = __builtin_amdgcn_exp2f(z.x); t.y = __builtin_amdgcn_exp2f(z.y);
    const f32x2 d = t + 1.0f;
    f32x2 s; s.x = __builtin_amdgcn_rcpf(d.x); s.y = __builtin_amdgcn_rcpf(d.y);
    return (g * s) * (l + 1.0f);
}
struct EpiSwiglu {
    static constexpr bool PERM = true, AUX = true, KSCALE = false; static constexpr int NST = 4;
    unsigned char* act; const float* b_gu; const float* rs; float wscale;
    __device__ __forceinline__ const float* rowsrc(const Unit& u) const { return rs + (size_t)u.pm * BM; }
    __device__ __forceinline__ const float* colsrc(const Unit& u, int w) const { return b_gu + (size_t)u.e * 2048 + (w >> 1) * 1024 + u.pl * HALF + (w & 1) * 64; }
    __device__ __forceinline__ void operator()(const f32x4 (&acc)[2][2][4][2], const Unit& u, int wr, int wc, int fr, int fq, const PG8_LAS float* aux, int ui) const {
        const int row0 = u.pm * BM + wr * 64 + fr, col0 = u.pl * HALF + wc * 32 + 8 * fq;
        const PG8_LAS float* bg = aux + 256 + wc * 32 + 8 * fq;
        const f32x4 g0 = *(const PG8_LAS f32x4*)(bg), g1 = *(const PG8_LAS f32x4*)(bg + 4), l0 = *(const PG8_LAS f32x4*)(bg + 128), l1 = *(const PG8_LAS f32x4*)(bg + 132);
#pragma unroll
        for (int ai = 0; ai < 2; ++ai)
#pragma unroll
            for (int mp = 0; mp < 2; ++mp) {
                unsigned w0[2], w1[2];
#pragma unroll
                for (int mm = 0; mm < 2; ++mm) { const int m = 2 * mp + mm;
                    const float r = aux[ai * HALF + wr * 64 + m * 16 + fr] * wscale;
                    const f32x4 a0 = acc[ai][0][m][0] * r + g0, a1 = acc[ai][0][m][1] * r + g1, b0 = acc[ai][1][m][0] * r + l0, b1 = acc[ai][1][m][1] * r + l1;
                    const f32x2 p0 = swiglu2((f32x2){a0[0], a0[1]}, (f32x2){b0[0], b0[1]}), p1 = swiglu2((f32x2){a0[2], a0[3]}, (f32x2){b0[2], b0[3]});
                    const f32x2 p2 = swiglu2((f32x2){a1[0], a1[1]}, (f32x2){b1[0], b1[1]}), p3 = swiglu2((f32x2){a1[2], a1[3]}, (f32x2){b1[2], b1[3]});
                    w0[mm] = pk_fp8x4(p0.x, p0.y, p1.x, p1.y); w1[mm] = pk_fp8x4(p2.x, p2.y, p3.x, p3.y); }
                const u32x2 s0 = __builtin_amdgcn_permlane16_swap(w0[0], w0[1], false, false), s1 = __builtin_amdgcn_permlane16_swap(w1[0], w1[1], false, false);
                const int row = row0 + ai * HALF + (2 * mp + (fq & 1)) * 16;
                *(u32x4*)(act + (size_t)row * 1024 + u.pl * HALF + wc * 32 + 16 * (fq >> 1)) = (u32x4){s0[0], s1[0], s0[1], s1[1]}; }
    }
};
struct EpiDown {
    static constexpr bool PERM = true, AUX = true, KSCALE = false; static constexpr int NST = 8;
    unsigned char* Y; const float* b_down; const float* gate; float wscale;
    __device__ __forceinline__ const float* rowsrc(const Unit& u) const { return gate + (size_t)u.pm * BM; }
    __device__ __forceinline__ const float* colsrc(const Unit& u, int w) const { return b_down + (size_t)u.e * 1024 + u.pl * BM + w * 64; }
    __device__ __forceinline__ void operator()(const f32x4 (&acc)[2][2][4][2], const Unit& u, int wr, int wc, int fr, int fq, const PG8_LAS float* aux, int ui) const {
        const int row0 = u.pm * BM + wr * 64 + fr, col0 = u.pl * BM + wc * 64 + 16 * fq;
        const PG8_LAS float* bd = aux + 256 + wc * 64 + 16 * fq;
        const f32x4 b00 = *(const PG8_LAS f32x4*)(bd), b01 = *(const PG8_LAS f32x4*)(bd + 4), b10 = *(const PG8_LAS f32x4*)(bd + 8), b11 = *(const PG8_LAS f32x4*)(bd + 12);
#pragma unroll
        for (int ai = 0; ai < 2; ++ai)
#pragma unroll
            for (int m = 0; m < 4; ++m) { const int rl = ai * HALF + wr * 64 + m * 16 + fr; const float gt = aux[rl] * 16.0f;
                const f32x4 lim = {440.f, 440.f, 440.f, 440.f};
                const f32x4 v0 = __builtin_elementwise_min(__builtin_elementwise_max((acc[ai][0][m][0] * wscale + b00) * gt, -lim), lim), v1 = __builtin_elementwise_min(__builtin_elementwise_max((acc[ai][0][m][1] * wscale + b01) * gt, -lim), lim),
                            v2 = __builtin_elementwise_min(__builtin_elementwise_max((acc[ai][1][m][0] * wscale + b10) * gt, -lim), lim), v3 = __builtin_elementwise_min(__builtin_elementwise_max((acc[ai][1][m][1] * wscale + b11) * gt, -lim), lim);
                u32x4 w; w.x = pk_fp8x4(v0[0], v0[1], v0[2], v0[3]); w.y = pk_fp8x4(v1[0], v1[1], v1[2], v1[3]); w.z = pk_fp8x4(v2[0], v2[1], v2[2], v2[3]); w.w = pk_fp8x4(v3[0], v3[1], v3[2], v3[3]);
                *(u32x4*)(Y + (size_t)(u.pm * BM + rl) * 1024 + col0) = w; }
    }
};
}
using pg8::pk_fp8x4;

__device__ __forceinline__ void transpose_load(const float* W, int ldw, int k0, int n0, float scale, LAS float* scr, int lane, const float* rowscale = nullptr) {
    float4 r[8]; float rsc[8];
#pragma unroll
    for (int i = 0; i < 8; ++i) { r[i] = ld_nt_f4(W + (size_t)(k0 + 8 * i + (lane >> 3)) * ldw + n0 + 4 * (lane & 7)); rsc[i] = rowscale ? rowscale[k0 + 8 * i + (lane >> 3)] * scale : scale; }
#pragma unroll
    for (int i = 0; i < 8; ++i) { LAS float* d = scr + (8 * i + (lane >> 3)) * 33 + 4 * (lane & 7); d[0] = r[i].x * rsc[i]; d[1] = r[i].y * rsc[i]; d[2] = r[i].z * rsc[i]; d[3] = r[i].w * rsc[i]; }
    asm volatile("s_waitcnt lgkmcnt(0)" ::: "memory");
}
__device__ __forceinline__ void transpose_item(const float* W, int ldw, int K, bf16* WT, int rowbase, int k0, int n0, LAS float* scr, int lane, const float* rowscale = nullptr) {
    transpose_load(W, ldw, k0, n0, 1.0f, scr, lane, rowscale);
    const int c = lane & 7;
#pragma unroll
    for (int j = 0; j < 4; ++j) { const int n = (lane >> 3) + 8 * j; const LAS float* s = scr + (8 * c) * 33 + n;
        uint4 o; o.x = pkbf(s[0 * 33], s[1 * 33]); o.y = pkbf(s[2 * 33], s[3 * 33]); o.z = pkbf(s[4 * 33], s[5 * 33]); o.w = pkbf(s[6 * 33], s[7 * 33]);
        *(uint4*)(WT + (size_t)(rowbase + n) * K + k0 + 8 * c) = o; }
    asm volatile("s_waitcnt lgkmcnt(0)" ::: "memory");
}

__device__ __forceinline__ void transpose_item_fp8(const float* W, int ldw, int K, unsigned char* WT, int rowbase, int k0, int n0, float scale, LAS float* scr, int lane) {
    transpose_load(W, ldw, k0, n0, scale, scr, lane);
    const int c = lane & 7;
#pragma unroll
    for (int j = 0; j < 4; ++j) { const int n = (lane >> 3) + 8 * j; const LAS float* s = scr + (8 * c) * 33 + n;
        uint2 o; o.x = pk_fp8x4(s[0 * 33], s[1 * 33], s[2 * 33], s[3 * 33]); o.y = pk_fp8x4(s[4 * 33], s[5 * 33], s[6 * 33], s[7 * 33]);
        *(uint2*)(WT + (size_t)(rowbase + n) * K + k0 + 8 * c) = o; }
    asm volatile("s_waitcnt lgkmcnt(0)" ::: "memory");
}

struct XDesc { const float* W; unsigned char* WT; int ldw, rowbase, k0, n0, perm; };
__device__ __forceinline__ XDesc xdesc(int r, const float* w_gu, const float* w_down, unsigned char* WguT, unsigned char* WdT) {
    XDesc d;
    if (r < 16384) { const int e = r >> 9, q = r & 511, kb = q >> 6, nb = q & 63, n0 = nb * 32;
        d.W = w_gu + (size_t)e * 1024 * 2048; d.WT = WguT; d.ldw = 2048; d.k0 = kb * 128; d.n0 = n0;
        d.rowbase = e * 2048 + ((n0 & 1023) >> 7) * 256 + (n0 >> 10) * 128 + (n0 & 127); d.perm = 0; }
    else { const int r2 = r - 16384, e = r2 >> 8, q = r2 & 255, kb = q >> 5, nb = q & 31;
        d.W = w_down + (size_t)e * 1024 * 1024; d.WT = WdT; d.ldw = 1024; d.k0 = kb * 128; d.n0 = nb * 32; { const int c0 = (nb * 32) & 255; d.rowbase = e * 1024 + ((nb * 32) & ~255) + 32 * (c0 >> 6) + 8 * ((c0 >> 4) & 3); } d.perm = 1; }
    return d;
}
__device__ __forceinline__ void xload(const XDesc& d, float4 (&r)[16], int lane) {
#pragma unroll
    for (int i = 0; i < 16; ++i) { const pg8::f32x4 t_ = __builtin_nontemporal_load((const pg8::f32x4*)(d.W + (size_t)(d.k0 + 8 * i + (lane >> 3)) * d.ldw + d.n0 + 4 * (lane & 7))); r[i] = make_float4(t_[0], t_[1], t_[2], t_[3]); }
}
__device__ __forceinline__ void xstore(const XDesc& d, const float4 (&r)[16], float scale, LAS float* scr, int lane) {
#pragma unroll
    for (int i = 0; i < 16; ++i) { LAS float* o = scr + (8 * i + (lane >> 3)) * 33 + 4 * (lane & 7); o[0] = r[i].x * scale; o[1] = r[i].y * scale; o[2] = r[i].z * scale; o[3] = r[i].w * scale; }
    asm volatile("s_waitcnt lgkmcnt(0)" ::: "memory");
    const int c = lane & 15;
#pragma unroll
    for (int j = 0; j < 8; ++j) { const int n = (lane >> 4) + 4 * j; const LAS float* s = scr + (8 * c) * 33 + n;
        uint2 o; o.x = pk_fp8x4(s[0 * 33], s[1 * 33], s[2 * 33], s[3 * 33]); o.y = pk_fp8x4(s[4 * 33], s[5 * 33], s[6 * 33], s[7 * 33]);
        const int row = d.rowbase + (d.perm ? 128 * ((n >> 3) & 1) + 8 * (n >> 4) + (n & 7) : n);
        *(uint2*)(d.WT + (size_t)row * 1024 + d.k0 + 8 * c) = o; }
    asm volatile("s_waitcnt lgkmcnt(0)" ::: "memory");
}

__device__ __forceinline__ void rms_row_bf16(const float* xr, const float* g, bf16* o, int lane, float4 (&v)[4]) {
    float s = 0.f;
#pragma unroll
    for (int j = 0; j < 4; ++j) { v[j] = ((const float4*)xr)[lane + 64 * j]; s += v[j].x * v[j].x + v[j].y * v[j].y + v[j].z * v[j].z + v[j].w * v[j].w; }
    s = wave_sum(s);
    const float rs = 1.0f / sqrtf(s * (1.0f / 1024.0f) + 1e-6f);
#pragma unroll
    for (int j = 0; j < 4; ++j) { const float4 gg = ((const float4*)g)[lane + 64 * j];
        v[j].x *= rs * gg.x; v[j].y *= rs * gg.y; v[j].z *= rs * gg.z; v[j].w *= rs * gg.w;
        ((uint2*)o)[lane + 64 * j] = make_uint2(pk2(v[j].x, v[j].y), pk2(v[j].z, v[j].w)); }
}
__device__ __forceinline__ void rms_row(const float* xr, const float* g, float* o, int lane, float4 (&v)[4]) {
    float s = 0.f;
#pragma unroll
    for (int j = 0; j < 4; ++j) { v[j] = ((const float4*)xr)[lane + 64 * j]; s += v[j].x * v[j].x + v[j].y * v[j].y + v[j].z * v[j].z + v[j].w * v[j].w; }
    s = wave_sum(s);
    const float rs = 1.0f / sqrtf(s * (1.0f / 1024.0f) + 1e-6f);
#pragma unroll
    for (int j = 0; j < 4; ++j) { const float4 gg = ((const float4*)g)[lane + 64 * j];
        v[j].x *= rs * gg.x; v[j].y *= rs * gg.y; v[j].z *= rs * gg.z; v[j].w *= rs * gg.w; ((float4*)o)[lane + 64 * j] = v[j]; }
}
typedef short bf16x8 __attribute__((ext_vector_type(8)));
typedef short s16x4 __attribute__((ext_vector_type(4)));
typedef float f32x4 __attribute__((ext_vector_type(4)));
typedef LAS s16x4 lds_s16x4;
typedef unsigned u32x4_t __attribute__((ext_vector_type(4)));
typedef unsigned u32x2_w __attribute__((ext_vector_type(2)));
#define MFMA16(a, b, c) __builtin_amdgcn_mfma_f32_16x16x32_bf16((a), (b), (c), 0, 0, 0)
__device__ __forceinline__ bf16x8 tr_frag(const LAS unsigned char* p0, const LAS unsigned char* p1) {
    const s16x4 a = __builtin_amdgcn_ds_read_tr16_b64_v4i16((lds_s16x4*)p0), b = __builtin_amdgcn_ds_read_tr16_b64_v4i16((lds_s16x4*)p1);
    return __builtin_shufflevector(a, b, 0, 1, 2, 3, 4, 5, 6, 7);
}
__device__ __forceinline__ bf16x8 pack8(const f32x4 a, const f32x4 b) {
    uint4 u; u.x = pkbf(a[0], a[1]); u.y = pkbf(a[2], a[3]); u.z = pkbf(b[0], b[1]); u.w = pkbf(b[2], b[3]); return __builtin_bit_cast(bf16x8, u);
}

constexpr int MA_PITCH = 272, MA_VOFF = 256 * MA_PITCH;
__device__ __forceinline__ void mem_attn_phase(LAS unsigned char* L, const bf16* projb, const bf16* kmem, const bf16* vmem, bf16* ycr, float* pss, int bid, int G) {
    int tid = threadIdx.x; asm volatile("" : "+v"(tid));
    const int lane = tid & 63, wave = __builtin_amdgcn_readfirstlane(tid >> 6), fr = lane & 15, g = lane >> 4, q = fr >> 2, pp = lane & 3;
    for (int u = bid; u < 256; u += G) {
        const int bh = u >> 4, chunk = u & 15, b = bh >> 2, hm = bh & 3;
        __syncthreads();
        {
            const u32x4_t* ksrc = (const u32x4_t*)(kmem + (size_t)bh * 256 * 128); const u32x4_t* vsrc = (const u32x4_t*)(vmem + (size_t)bh * 256 * 128);
            u32x4_t kr[8], vr[8];
#pragma unroll
            for (int i = 0; i < 8; ++i) { kr[i] = ksrc[tid + 512 * i]; vr[i] = vsrc[tid + 512 * i]; }
#pragma unroll
            for (int i = 0; i < 8; ++i) { const int pc = tid + 512 * i, row = pc >> 4, ch = pc & 15;
                *(LAS u32x4_t*)(L + row * MA_PITCH + ch * 16) = kr[i]; *(LAS u32x4_t*)(L + MA_VOFF + row * MA_PITCH + ch * 16) = vr[i]; }
        }
        __syncthreads();
        for (int ti = wave; ti < 32; ti += 8) {
            const int tok = (b << 13) + chunk * 512 + ti * 16 + fr;
            bf16x8 qf[4];
#pragma unroll
            for (int kc = 0; kc < 4; ++kc) qf[kc] = __builtin_nontemporal_load((const bf16x8*)(projb + (size_t)tok * PW + 2048 + hm * 128 + 32 * kc + 8 * g));
            f32x4 s[16];
#pragma unroll
            for (int kb = 0; kb < 16; ++kb) { s[kb] = (f32x4){0.f, 0.f, 0.f, 0.f};
#pragma unroll
                for (int kc = 0; kc < 4; ++kc) { const bf16x8 kf = *(const LAS bf16x8*)(L + (16 * kb + fr) * MA_PITCH + (32 * kc + 8 * g) * 2); s[kb] = MFMA16(kf, qf[kc], s[kb]); }
                if (kb & 1) __builtin_amdgcn_sched_barrier(0); }
            const float sc = 0.08838834764831845f * 1.4426950408889634f;
            float mx = -3.0e38f;
#pragma unroll
            for (int kb = 0; kb < 16; ++kb) { s[kb] = s[kb] * sc; mx = fmaxf(mx, fmaxf(fmaxf(s[kb][0], s[kb][1]), fmaxf(s[kb][2], s[kb][3]))); }
            mx = fmaxf(mx, __shfl_xor(mx, 16)); mx = fmaxf(mx, __shfl_xor(mx, 32));
            float sum = 0.f;
#pragma unroll
            for (int kb = 0; kb < 16; ++kb) {
#pragma unroll
                for (int i = 0; i < 4; ++i) { const float e = __builtin_amdgcn_exp2f(s[kb][i] - mx); s[kb][i] = e; sum += e; } }
            sum += __shfl_xor(sum, 16); sum += __shfl_xor(sum, 32);
            f32x4 o[8];
#pragma unroll
            for (int db = 0; db < 8; ++db) o[db] = (f32x4){0.f, 0.f, 0.f, 0.f};
#pragma unroll
            for (int c = 0; c < 8; ++c) {
                const bf16x8 pf = pack8(s[2 * c], s[2 * c + 1]);
                const LAS unsigned char* vb = L + MA_VOFF + (32 * c + 4 * g + q) * MA_PITCH + 8 * pp;
#pragma unroll
                for (int db = 0; db < 8; ++db) { const bf16x8 vf = tr_frag(vb + 32 * db, vb + 16 * MA_PITCH + 32 * db); o[db] = MFMA16(vf, pf, o[db]); }
                __builtin_amdgcn_sched_barrier(0);
            }
            const float inv = 1.0f / sum;
            bf16* orow0 = ycr + (size_t)tok * MIXW + 1024 + hm * 128;
            float ss = 0.f;
#pragma unroll
            for (int dp = 0; dp < 4; ++dp) { unsigned x0[2], x1[2];
#pragma unroll
                for (int t = 0; t < 2; ++t) { const f32x4 v = o[2 * dp + t] * inv; ss += (v[0] * v[0] + v[1] * v[1]) + (v[2] * v[2] + v[3] * v[3]); x0[t] = pkbf(v[0], v[1]); x1[t] = pkbf(v[2], v[3]); }
                const u32x2_w s0 = __builtin_amdgcn_permlane16_swap(x0[0], x0[1], false, false), s1 = __builtin_amdgcn_permlane16_swap(x1[0], x1[1], false, false);
                *(u32x4_t*)(orow0 + 16 * (2 * dp + (g & 1)) + 8 * (g >> 1)) = (u32x4_t){s0[0], s1[0], s0[1], s1[1]}; }
            ss += __shfl_xor(ss, 16); ss += __shfl_xor(ss, 32);
            if (g == 0) pss[(size_t)tok * 12 + 8 + hm] = ss;
        }
    }
    __syncthreads();
}

constexpr int NA_PITCH = 144, NA_VOFF = 512 * NA_PITCH, NA_BOFF = 2 * 512 * NA_PITCH;
__device__ __forceinline__ void na_attn_phase(LAS unsigned char* L, const bf16* projb, const float* rel_bias, bf16* ycr, float* pss, int bid, int G) {
    int tid = threadIdx.x; asm volatile("" : "+v"(tid));
    const int lane = tid & 63, wave = __builtin_amdgcn_readfirstlane(tid >> 6), fr = lane & 15, g = lane >> 4, q = fr >> 2, pp = lane & 3;
    LAS float* bias_s = (LAS float*)(L + NA_BOFF);
    for (int sq = bid; sq < 256; sq += G) {
        const int qb = sq & 3, h = (sq >> 2) & 7, half = (sq >> 5) & 1, b = sq >> 6;
        const int c0 = qb == 0 ? 0 : qb == 1 ? 8 : qb == 2 ? 24 : 32;
        __syncthreads();
        {
            const int r0 = 64 * half, wr0 = min(max(r0 - 4, 0), 120), wr1 = min(r0 + 3, 120) + 7, nrows = wr1 - wr0 + 1;
            u32x4_t rg[15];
#pragma unroll
            for (int i = 0; i < 15; ++i) {
                if (i < nrows) { const int cc = tid >> 4, part = tid & 15, isv = part >> 3, ch = part & 7;
                    const int tok = (b << 13) + (wr0 + i) * 64 + c0 + cc;
                    rg[i] = *(const u32x4_t*)(projb + (size_t)tok * PW + (isv ? 1024 : 512) + h * 64 + ch * 8); } }
#pragma unroll
            for (int i = 0; i < 15; ++i) {
                if (i < nrows) { const int cc = tid >> 4, part = tid & 15, isv = part >> 3, ch = part & 7;
                    *(LAS u32x4_t*)(L + (isv ? NA_VOFF : 0) + (((wr0 + i) & 15) * 32 + cc) * NA_PITCH + ch * 16) = rg[i]; } }
            if (tid < 465) bias_s[16 + tid] = rel_bias[h * 465 + tid] * 1.4426950408889634f;
        }
        for (int i8 = 0; i8 < 8; ++i8) {
            const int ro = 8 * half + i8, r0 = 8 * ro, wr1 = min(r0 + 3, 120) + 7;
            const int nnew = i8 < 7 ? (min(r0 + 11, 120) + 7) - wr1 : 0;
            __syncthreads();
            const int r = r0 + wave, rs = min(max(r - 4, 0), 120);
            const int cq = 16 * qb + fr, cs = min(max(cq - 8, 0), 48);
            const int tok = (b << 13) + r * 64 + cq;
            bf16x8 qf[2];
#pragma unroll
            for (int kc = 0; kc < 2; ++kc) qf[kc] = __builtin_nontemporal_load((const bf16x8*)(projb + (size_t)tok * PW + h * 64 + 32 * kc + 8 * g));
            asm volatile("" ::: "memory");
            u32x4_t rn[8];
#pragma unroll
            for (int i = 0; i < 8; ++i) { const int lr = i < nnew ? i : (nnew > 0 ? nnew - 1 : 0), key = tid >> 4, part = tid & 15, isv = part >> 3, ch = part & 7;
                const int tokn = (b << 13) + min(wr1 + 1 + lr, 127) * 64 + c0 + key;
                rn[i] = *(const u32x4_t*)(projb + (size_t)tokn * PW + (isv ? 1024 : 512) + h * 64 + ch * 8); }
            f32x4 s[16];
            float bv[8][4], bw[8][4];
            const LAS float* bp0 = bias_s + 16 + (rs - r + 7) * 31 + 15 + (c0 + 4 * g - cq);
#pragma unroll
            for (int kq = 0; kq < 4; ++kq) {
                bf16x8 kf[4][2];
#pragma unroll
                for (int kk = 0; kk < 4; ++kk) { const int kb = 4 * kq + kk;
                    const LAS unsigned char* kp = L + ((((rs + (kb >> 1)) & 15)) * 32 + 16 * (kb & 1) + fr) * NA_PITCH + 16 * g;
                    kf[kk][0] = *(const LAS bf16x8*)kp; kf[kk][1] = *(const LAS bf16x8*)(kp + 64); }
                if (kq == 0) {
#pragma unroll
                    for (int kb = 0; kb < 8; ++kb)
#pragma unroll
                        for (int i = 0; i < 4; ++i) bv[kb][i] = bp0[16 * (kb & 1) + 31 * (kb >> 1) + i]; }
                __builtin_amdgcn_sched_barrier(0);
#pragma unroll
                for (int kk = 0; kk < 4; ++kk) { const int kb = 4 * kq + kk; s[kb] = MFMA16(kf[kk][0], qf[0], ((f32x4){0.f, 0.f, 0.f, 0.f})); s[kb] = MFMA16(kf[kk][1], qf[1], s[kb]); }
                __builtin_amdgcn_sched_barrier(0);
            }
            bool okc[2][4];
#pragma unroll
            for (int hf = 0; hf < 2; ++hf)
#pragma unroll
                for (int i = 0; i < 4; ++i) { const int ck = c0 + 16 * hf + 4 * g + i; okc[hf][i] = (ck >= cs) && (ck < cs + 16); }
#pragma unroll
            for (int kb = 8; kb < 16; ++kb)
#pragma unroll
                for (int i = 0; i < 4; ++i) bw[kb - 8][i] = bp0[16 * (kb & 1) + 31 * (kb >> 1) + i];
            __builtin_amdgcn_sched_barrier(0);
            float mx = -3.0e38f;
#pragma unroll
            for (int kb = 0; kb < 16; ++kb) {
                const int hf = kb & 1;
#pragma unroll
                for (int i = 0; i < 4; ++i) { const float v = okc[hf][i] ? fmaf(s[kb][i], 0.125f * 1.4426950408889634f, kb < 8 ? bv[kb][i] : bw[kb - 8][i]) : -3.0e38f; s[kb][i] = v; mx = fmaxf(mx, v); } }
            mx = fmaxf(mx, __shfl_xor(mx, 16)); mx = fmaxf(mx, __shfl_xor(mx, 32));
            float sum = 0.f;
#pragma unroll
            for (int kb = 0; kb < 16; ++kb) {
#pragma unroll
                for (int i = 0; i < 4; ++i) { const float e = __builtin_amdgcn_exp2f(s[kb][i] - mx); s[kb][i] = e; sum += e; } }
            sum += __shfl_xor(sum, 16); sum += __shfl_xor(sum, 32);
            f32x4 o[4];
#pragma unroll
            for (int db = 0; db < 4; ++db) o[db] = (f32x4){0.f, 0.f, 0.f, 0.f};
#pragma unroll
            for (int jp = 0; jp < 4; ++jp) {
                bf16x8 vf[2][4];
#pragma unroll
                for (int jj = 0; jj < 2; ++jj) { const int j = 2 * jp + jj;
                    const LAS unsigned char* vb = L + NA_VOFF + (((rs + j) & 15) * 32 + 4 * g + q) * NA_PITCH + 8 * pp;
#pragma unroll
                    for (int db = 0; db < 4; ++db) vf[jj][db] = tr_frag(vb + 32 * db, vb + 16 * NA_PITCH + 32 * db); }
                __builtin_amdgcn_sched_barrier(0);
#pragma unroll
                for (int jj = 0; jj < 2; ++jj) { const int j = 2 * jp + jj; const bf16x8 pf = pack8(s[2 * j], s[2 * j + 1]);
#pragma unroll
                    for (int db = 0; db < 4; ++db) o[db] = MFMA16(vf[jj][db], pf, o[db]); }
                __builtin_amdgcn_sched_barrier(0);
            }
            const float inv = 1.0f / sum;
            bf16* orow0 = ycr + (size_t)tok * MIXW + h * 64;
            float ss = 0.f;
#pragma unroll
            for (int dp = 0; dp < 2; ++dp) { unsigned x0[2], x1[2];
#pragma unroll
                for (int t = 0; t < 2; ++t) { const f32x4 v = o[2 * dp + t] * inv; ss += (v[0] * v[0] + v[1] * v[1]) + (v[2] * v[2] + v[3] * v[3]); x0[t] = pkbf(v[0], v[1]); x1[t] = pkbf(v[2], v[3]); }
                const u32x2_w s0 = __builtin_amdgcn_permlane16_swap(x0[0], x0[1], false, false), s1 = __builtin_amdgcn_permlane16_swap(x1[0], x1[1], false, false);
                *(u32x4_t*)(orow0 + 16 * (2 * dp + (g & 1)) + 8 * (g >> 1)) = (u32x4_t){s0[0], s1[0], s0[1], s1[1]}; }
            ss += __shfl_xor(ss, 16); ss += __shfl_xor(ss, 32);
            if (g == 0) pss[(size_t)tok * 12 + h] = ss;
            __syncthreads();
#pragma unroll
            for (int i = 0; i < 8; ++i)
                if (i < nnew) { const int key = tid >> 4, part = tid & 15, isv = part >> 3, ch = part & 7;
                    *(LAS u32x4_t*)(L + (isv ? NA_VOFF : 0) + (((wr1 + 1 + i) & 15) * 32 + key) * NA_PITCH + ch * 16) = rn[i]; }
        }
    }
    __syncthreads();
}
typedef unsigned u32x2_t __attribute__((ext_vector_type(2)));
constexpr int FT_PITCH = 528, FT_OS1 = 128 * FT_PITCH;
constexpr int FT_UP = 272;
__device__ __forceinline__ void ft_stage1_phase(LAS unsigned char* L, const bf16* projb, bf16* Mid, const bf16* tabC, const bf16* tabS, const bf16* tabSn, const float2* tab8192, int bid, int G) {
    int tid = threadIdx.x; asm volatile("" : "+v"(tid));
    const int lane = tid & 63, wave = __builtin_amdgcn_readfirstlane(tid >> 6), fr = lane & 15, g4 = lane >> 4, q = fr >> 2, pp = lane & 3;
    bf16x8 fC[4], fS[4], fSn[4], fD[2][4];
#pragma unroll
    for (int kc = 0; kc < 4; ++kc) { const size_t o = (size_t)(16 * wave + fr) * 128 + 32 * kc + 8 * g4; fC[kc] = *(const bf16x8*)(tabC + o); fS[kc] = *(const bf16x8*)(tabS + o); fSn[kc] = *(const bf16x8*)(tabSn + o);
#pragma unroll
        for (int t = 0; t < 2; ++t) { const int nb = 2 * wave + t; const bf16* tb = nb < 8 ? tabC : tabSn; fD[t][kc] = *(const bf16x8*)(tb + (size_t)(16 * (nb & 7) + fr) * 128 + 32 * kc + 8 * g4); } }
    for (int u = bid; u < 1024; u += G) {
        const int g = u & 3, c = (u >> 2) & 63, b = u >> 8;
        {
            u32x4_t rg[4];
#pragma unroll
            for (int i = 0; i < 4; ++i) { const int pc = tid + 512 * i, r = pc >> 4, ch = pc & 15; rg[i] = __builtin_nontemporal_load((const u32x4_t*)(projb + (size_t)((b << 13) + 64 * r + c) * PW + 1536 + g * 128 + ch * 8)); }
#pragma unroll
            for (int i = 0; i < 4; ++i) { const int pc = tid + 512 * i, r = pc >> 4, ch = pc & 15; *(LAS u32x4_t*)(L + FT_OS1 + r * FT_UP + ch * 16) = rg[i]; }
        }
        __syncthreads();
        {
#pragma unroll
            for (int mb = 0; mb < 8; ++mb) {
                f32x4 v0 = {0.f, 0.f, 0.f, 0.f}, v1 = {0.f, 0.f, 0.f, 0.f};
#pragma unroll
                for (int kc = 0; kc < 4; ++kc) { const bf16x8 bu = *(const LAS bf16x8*)(L + FT_OS1 + (16 * mb + fr) * FT_UP + (32 * kc + 8 * g4) * 2);
                    v0 = MFMA16(fD[0][kc], bu, v0); v1 = MFMA16(fD[1][kc], bu, v1); }
                LAS unsigned char* xr = L + (16 * mb + fr) * FT_PITCH + (32 * wave + 4 * g4) * 2;
                *(LAS u32x2_t*)(xr) = (u32x2_t){pkbf(v0[0], v0[1]), pkbf(v0[2], v0[3])};
                *(LAS u32x2_t*)(xr + 32) = (u32x2_t){pkbf(v1[0], v1[1]), pkbf(v1[2], v1[3])};
            }
        }
        __syncthreads();
        {
            const int k1 = 16 * wave + fr;
            const float2 tw = tab8192[k1 * c];
            LAS unsigned char* orow = L + FT_OS1 + k1 * FT_PITCH + 8 * g4;
#pragma unroll
            for (int nb = 0; nb < 8; ++nb) {
                f32x4 re = {0.f, 0.f, 0.f, 0.f}, im = {0.f, 0.f, 0.f, 0.f};
#pragma unroll
                for (int kc = 0; kc < 4; ++kc) {
                    const LAS unsigned char* xp = L + (32 * kc + 8 * g4 + q) * FT_PITCH + 32 * nb + 8 * pp;
                    const bf16x8 ar = tr_frag(xp, xp + 4 * FT_PITCH), ai = tr_frag(xp + 256, xp + 256 + 4 * FT_PITCH);
                    re = MFMA16(ar, fC[kc], re); re = MFMA16(ai, fS[kc], re); im = MFMA16(ai, fC[kc], im); im = MFMA16(ar, fSn[kc], im);
                }
                const f32x4 ore = re * tw.x + im * tw.y, oim = im * tw.x - re * tw.y;
                *(LAS u32x2_t*)(orow + 32 * nb) = (u32x2_t){pkbf(ore[0], ore[1]), pkbf(ore[2], ore[3])};
                *(LAS u32x2_t*)(orow + 256 + 32 * nb) = (u32x2_t){pkbf(oim[0], oim[1]), pkbf(oim[2], oim[3])};
                __builtin_amdgcn_sched_barrier(0);
            }
        }
        __syncthreads();
        {
#pragma unroll
            for (int i = 0; i < 8; ++i) { const int pc = tid + 512 * i, k1 = pc >> 5, ch = pc & 31;
                *(u32x4_t*)(Mid + ((size_t)(((b * 128 + k1) * 4 + g) * 64 + c)) * 256 + ch * 8) = *(const LAS u32x4_t*)(L + FT_OS1 + k1 * FT_PITCH + ch * 16); }
        }
        __syncthreads();
    }
    __syncthreads();
}
constexpr int FT_XS2 = 64 * FT_PITCH, FT_OS2 = 2 * FT_XS2, FT_OP2 = 1040;
__device__ __forceinline__ void ft_stage2_phase(LAS unsigned char* L, const bf16* Mid, bf16* yout, const bf16* tab2, float* pss2, int bid, int G) {
    int tid = threadIdx.x; asm volatile("" : "+v"(tid));
    const int lane = tid & 63, wave = __builtin_amdgcn_readfirstlane(tid >> 6), fr = lane & 15, g4 = lane >> 4, q = fr >> 2, pp = lane & 3;
    bf16x8 fT[4][4];
#pragma unroll
    for (int kb = 0; kb < 4; ++kb)
#pragma unroll
        for (int kc = 0; kc < 4; ++kc) fT[kb][kc] = *(const bf16x8*)(tab2 + (size_t)(16 * kb + fr) * 128 + 32 * kc + 8 * g4);
    for (int u = bid; u < 512; u += G) {
        const int k1 = u & 127, b = u >> 7;
        const bf16* src = Mid + (size_t)((b * 128 + k1) * 4) * 64 * 256;
        u32x4_t rg[4];
#pragma unroll
        for (int i = 0; i < 4; ++i) rg[i] = __builtin_nontemporal_load((const u32x4_t*)(src + (size_t)(tid + 512 * i) * 8));
#pragma unroll
        for (int i = 0; i < 4; ++i) { const int pc = tid + 512 * i, c = pc >> 5, ch = pc & 31; *(LAS u32x4_t*)(L + c * FT_PITCH + ch * 16) = rg[i]; }
        __syncthreads();
#pragma unroll
        for (int g = 0; g < 4; ++g) {
            if (g < 3) {
#pragma unroll
                for (int i = 0; i < 4; ++i) rg[i] = __builtin_nontemporal_load((const u32x4_t*)(src + (size_t)(g + 1) * 64 * 256 + (size_t)(tid + 512 * i) * 8));
            }
            const LAS unsigned char* X = L + (g & 1) * FT_XS2;
            f32x4 acc[4];
#pragma unroll
            for (int kb = 0; kb < 4; ++kb) acc[kb] = (f32x4){0.f, 0.f, 0.f, 0.f};
#pragma unroll
            for (int kc = 0; kc < 4; ++kc) {
                const LAS unsigned char* xp = X + (32 * (kc & 1) + 8 * g4 + q) * FT_PITCH + (kc >> 1) * 256 + 32 * wave + 8 * pp;
                const bf16x8 a = tr_frag(xp, xp + 4 * FT_PITCH);
#pragma unroll
                for (int kb = 0; kb < 4; ++kb) acc[kb] = MFMA16(a, fT[kb][kc], acc[kb]);
            }
#pragma unroll
            for (int kb = 0; kb < 4; ++kb) { const f32x4 v = acc[kb] * (1.0f / 1024.0f);
                *(LAS u32x2_t*)(L + FT_OS2 + (16 * kb + fr) * FT_OP2 + (g * 128 + 16 * wave + 4 * g4) * 2) = (u32x2_t){pkbf(v[0], v[1]), pkbf(v[2], v[3])}; }
            if (g < 3) {
#pragma unroll
                for (int i = 0; i < 4; ++i) { const int pc = tid + 512 * i, c = pc >> 5, ch = pc & 31; *(LAS u32x4_t*)(L + ((g + 1) & 1) * FT_XS2 + c * FT_PITCH + ch * 16) = rg[i]; }
            }
            __syncthreads();
        }
#pragma unroll
        for (int j = 0; j < 8; ++j) {
            const int k2 = 8 * wave + j;
            const u32x4_t raw = *(const LAS u32x4_t*)(L + FT_OS2 + k2 * FT_OP2 + lane * 16);
            float f0 = __builtin_bit_cast(float, raw.x << 16), f1 = __builtin_bit_cast(float, raw.x & 0xffff0000u), f2 = __builtin_bit_cast(float, raw.y << 16), f3 = __builtin_bit_cast(float, raw.y & 0xffff0000u);
            float f4 = __builtin_bit_cast(float, raw.z << 16), f5 = __builtin_bit_cast(float, raw.z & 0xffff0000u), f6 = __builtin_bit_cast(float, raw.w << 16), f7 = __builtin_bit_cast(float, raw.w & 0xffff0000u);
            float s = (f0 * f0 + f1 * f1) + (f2 * f2 + f3 * f3) + (f4 * f4 + f5 * f5) + (f6 * f6 + f7 * f7);
            s = wave_sum(s);
            const size_t tok = (size_t)((b << 13) + k1 + 128 * k2);
            *(u32x4_t*)(yout + tok * MIXW + 512 + lane * 8) = raw;
            if (lane == 0) pss2[tok] = s;
        }
    }
    __syncthreads();
}

template <class AF, class BF>
__device__ __forceinline__ void naive_tile(float* sm, int K, AF af, BF bf, float (&acc)[8][4]) {
    float (*As)[132] = (float (*)[132])sm; float (*Bs)[132] = (float (*)[132])(sm + 16 * 132);
    const int tid = threadIdx.x, tx = tid & 31, ty = tid >> 5;
#pragma unroll
    for (int i = 0; i < 8; ++i)
#pragma unroll
        for (int j = 0; j < 4; ++j) acc[i][j] = 0.f;
    for (int k0 = 0; k0 < K; k0 += 16) {
        { const int r = tid >> 2, kk = (tid & 3) * 4;
#pragma unroll
          for (int j = 0; j < 4; ++j) As[kk + j][r] = af(r, k0 + kk + j); }
        { const int kk = tid >> 5, c = (tid & 31) * 4;
#pragma unroll
          for (int j = 0; j < 4; ++j) Bs[kk][c + j] = bf(k0 + kk, c + j); }
        __syncthreads();
#pragma unroll
        for (int kk = 0; kk < 16; ++kk) {
            float a[8], b[4];
#pragma unroll
            for (int i = 0; i < 8; ++i) a[i] = As[kk][ty * 8 + i];
#pragma unroll
            for (int j = 0; j < 4; ++j) b[j] = Bs[kk][(j >> 1) * 64 + tx * 2 + (j & 1)];
#pragma unroll
            for (int i = 0; i < 8; ++i)
#pragma unroll
                for (int j = 0; j < 4; ++j) acc[i][j] += a[i] * b[j];
        }
        __syncthreads();
    }
}

#define PHASE_IDS int tid_ = threadIdx.x; asm volatile("" : "+v"(tid_)); const int tid = tid_, lane = tid & 63, wave = __builtin_amdgcn_readfirstlane(tid >> 6); (void)lane; (void)wave;
__global__ void __launch_bounds__(NTH, 2) mk_fwd(Params p) {
    extern __shared__ __attribute__((aligned(16))) unsigned char lds[];
    const int tid = threadIdx.x, lane = tid & 63, wave = __builtin_amdgcn_readfirstlane(tid >> 6);
    const int G = gridDim.x, bid = blockIdx.x;
    unsigned char* ws = p.ws;
    unsigned* ctl = (unsigned*)(ws + WS_CTL);
    LAS unsigned char* L = (LAS unsigned char*)lds;
    volatile LAS unsigned* xbw = (volatile LAS unsigned*)(L + LDS_XBW);
    if (tid < 4) xbw[tid] = 0u;
    __syncthreads();
    XcdBarrier bar = xcd_barrier_post(ctl + CW_BAR, xbw);
    float* sm = (float*)lds;
    LAS int* sbase = (LAS int*)(L + LDS_SBASE); LAS int* scnt = (LAS int*)(L + LDS_SBASE + 256); LAS int* tile_e = (LAS int*)(L + LDS_TILEE); LAS int* idxbuf = (LAS int*)(L + LDS_IDX);

    float2* tab128 = (float2*)(ws + WS_TAB128); float2* tab64 = (float2*)(ws + WS_TAB64); float2* tab8192 = (float2*)(ws + WS_TAB8192);
    bf16* memn = (bf16*)(ws + WS_MEMN); bf16* WkvT = (bf16*)(ws + WS_WKV); bf16* kmem = (bf16*)(ws + WS_KMEM); bf16* vmem = (bf16*)(ws + WS_VMEM);
    unsigned* bbase = (unsigned*)(ws + WS_BBASE);
    int* ident = (int*)(ws + WS_IDENT); float* pss = (float*)(ws + WS_PSS); float* pss2 = (float*)(ws + WS_PSS2);
    float* rsbuf = (float*)(ws + WS_RSBUF); float* slot_rs = (float*)(ws + WS_SLOTRS); bf16* RwH = (bf16*)(ws + WS_RWH); bf16* RwL = (bf16*)(ws + WS_RWL);
    int* tok_e = (int*)(ws + WS_TOKE); float* tok_g = (float*)(ws + WS_TOKG); int* tok_pos = (int*)(ws + WS_TOKPOS); int* tok_slot = (int*)(ws + WS_TOKSLOT);
    int* slot_tok = (int*)(ws + WS_SLOTTOK); float* slot_gate = (float*)(ws + WS_SLOTGATE);
    bf16* WinT = (bf16*)(ws + WS_WIN); bf16* WoutT = (bf16*)(ws + WS_WOUT); unsigned char* WguT = ws + WS_WGU; unsigned char* WdT = ws + WS_WD; unsigned char* h8 = ws + WS_H8; unsigned char* act = ws + WS_PROJ;
    bf16* hb = (bf16*)(ws + WS_HB); bf16* projb = (bf16*)(ws + WS_PROJ); bf16* Mid = (bf16*)(ws + WS_MID);
    bf16* tabC = (bf16*)(ws + WS_TABC); bf16* tabS = (bf16*)(ws + WS_TABS); bf16* tabSn = (bf16*)(ws + WS_TABSN); bf16* tab2 = (bf16*)(ws + WS_TAB2);
    bf16* ycr = (bf16*)(ws + WS_YCAT); unsigned char* Yb = ws + WS_Y; bf16* ycatn = (bf16*)(ws + WS_YCATN); bf16* Vbuf = (bf16*)(ws + WS_V);
    bf16* x1b = hb;

    {
        PHASE_IDS
        for (int i = bid * NTH + tid; i < 8192; i += G * NTH) {
            tab8192[i] = make_float2(cospif(2.0f * (float)i / 8192.0f), sinpif(2.0f * (float)i / 8192.0f));
            if (i < 128) tab128[i] = make_float2(cospif(2.0f * (float)i / 128.0f), sinpif(2.0f * (float)i / 128.0f));
            if (i < 64) tab64[i] = make_float2(cospif(2.0f * (float)i / 64.0f), sinpif(2.0f * (float)i / 64.0f));
        }
        for (int i = bid * NTH + tid; i < 32 * 1024; i += G * NTH) {
            const int e = i >> 10, k = i & 1023; const float w = p.router_w[(size_t)k * 32 + e]; const unsigned hi = f2bf(w);
            RwH[i] = (bf16)hi; RwL[i] = (bf16)f2bf(w - bf2f((bf16)hi));
        }
        for (int i = bid * NTH + tid; i < 128 * 128; i += G * NTH) {
            const int k1 = i >> 7, r = i & 127, ph = (k1 * r) & 127; const float cs = cospif(2.0f * (float)ph / 128.0f), sn = sinpif(2.0f * (float)ph / 128.0f);
            tabC[i] = (bf16)f2bf(cs); tabS[i] = (bf16)f2bf(sn); tabSn[i] = (bf16)f2bf(-sn);
            if (i < 64 * 128) { const int k2 = i >> 7, kk = i & 127, c = kk & 63, p2 = (k2 * c) & 63; tab2[i] = (bf16)f2bf(kk < 64 ? cospif(2.0f * (float)p2 / 64.0f) : sinpif(2.0f * (float)p2 / 64.0f)); }
        }
        LAS float* scr = (LAS float*)(L + wave * 17408);
        const int gw = bid * 8 + wave, NGW = G * 8;
        constexpr int I_IN = 16 * 80, I_OUT = 24 * 32, I_KV = 16 * 32;
        for (int it = gw; it < I_KV + I_IN + I_OUT; it += NGW) {
            int r = it;
            if (r < I_KV) { const int kb = r / 32, nb = r % 32; transpose_item(p.w_mem_kv, 1024, 1024, WkvT, nb * 32, kb * 64, nb * 32, scr, lane); continue; } r -= I_KV;
            if (r < I_IN) { const int kb = r / 80, nb = r % 80; transpose_item(p.w_in, INW, 1024, WinT, nb * 32, kb * 64, nb * 32, scr, lane); continue; } r -= I_IN;
            { const int kb = r / 32, nb = r % 32; transpose_item(p.w_out, 1024, MIXW, WoutT, nb * 32, kb * 64, nb * 32, scr, lane, p.g_grp); }
        }
        for (int m = 2 * gw; m < T; m += 2 * NGW) {
            float4 va[4], vb[4]; float sa = 0.f, sb = 0.f;
#pragma unroll
            for (int j = 0; j < 4; ++j) { va[j] = ld_nt_f4(p.x + (size_t)m * D + 4 * (lane + 64 * j)); vb[j] = ld_nt_f4(p.x + (size_t)(m + 1) * D + 4 * (lane + 64 * j)); }
#pragma unroll
            for (int j = 0; j < 4; ++j) { sa += va[j].x * va[j].x + va[j].y * va[j].y + va[j].z * va[j].z + va[j].w * va[j].w; sb += vb[j].x * vb[j].x + vb[j].y * vb[j].y + vb[j].z * vb[j].z + vb[j].w * vb[j].w; }
            sa = wave_sum(sa); sb = wave_sum(sb);
            const float ra = 1.0f / sqrtf(sa * (1.0f / 1024.0f) + 1e-6f), rb = 1.0f / sqrtf(sb * (1.0f / 1024.0f) + 1e-6f);
#pragma unroll
            for (int j = 0; j < 4; ++j) { const float4 gg = ((const float4*)p.g_mix)[lane + 64 * j];
                ((uint2*)(hb + (size_t)m * D))[lane + 64 * j] = make_uint2(pkbf(va[j].x * ra * gg.x, va[j].y * ra * gg.y), pkbf(va[j].z * ra * gg.z, va[j].w * ra * gg.w));
                ((uint2*)(hb + (size_t)(m + 1) * D))[lane + 64 * j] = make_uint2(pkbf(vb[j].x * rb * gg.x, vb[j].y * rb * gg.y), pkbf(vb[j].z * rb * gg.z, vb[j].w * rb * gg.w)); }
        }
        { float4 v[4]; for (int m = gw; m < 1024; m += NGW) rms_row_bf16(p.mem + (size_t)m * D, p.g_mem, memn + (size_t)m * D, lane, v); }
    }
    xcd_barrier(bar);

    {
        PHASE_IDS
        pg8::Gemm g{hb, WinT, 1024}; pg8::GroupOrder S; S.init(T / 256, 10, 8, G, bid, nullptr, nullptr);
        pg8::EpiBf16Plain E{projb, PW};
        pg8::SideGu SD{p.w_gu, WguT, 0, 80, bid};
        pg8::gemm_phase<pg8::EpiBf16Plain, pg8::GroupOrder, false, false, pg8::SideGu>(L, idxbuf, g, S, E, SD);
        {
            const int fr = lane & 15, g4 = lane >> 4;
            for (int tile = bid * 8 + wave; tile < 2048; tile += G * 8) {
                const int rt = tile >> 5, cp = tile & 31;
                f32x4 c0 = {0.f, 0.f, 0.f, 0.f}, c1 = {0.f, 0.f, 0.f, 0.f};
                const bf16* ap = memn + (size_t)(16 * rt + fr) * 1024 + 8 * g4; const bf16* bp = WkvT + (size_t)(32 * cp + fr) * 1024 + 8 * g4;
#pragma unroll 4
                for (int kc = 0; kc < 32; ++kc) { const bf16x8 a = *(const bf16x8*)(ap + 32 * kc), b0 = *(const bf16x8*)(bp + 32 * kc), b1 = *(const bf16x8*)(bp + 16 * 1024 + 32 * kc);
                    c0 = MFMA16(a, b0, c0); c1 = MFMA16(a, b1, c1); }
#pragma unroll
                for (int nb = 0; nb < 2; ++nb) { const int n = 32 * cp + 16 * nb + fr, isv = n >> 9, hm = (n >> 7) & 3, d = n & 127; bf16* dst = isv ? vmem : kmem;
#pragma unroll
                    for (int i = 0; i < 4; ++i) { const int row = 16 * rt + 4 * g4 + i, b = row >> 8, m = row & 255;
                        dst[((size_t)((b * 4 + hm) * 256 + m)) * 128 + d] = (bf16)f2bf(nb ? c1[i] : c0[i]); } }
            }
        }
    }
    xcd_barrier(bar);

#define WD_CONVERT() do { __syncthreads(); { PHASE_IDS LAS float* xscr = (LAS float*)(L + wave * 17408); const int gw = bid * 8 + wave, NGW = G * 8; \
            constexpr int I_X2 = 16384 + 8192; \
            int it = 16384 + gw; float4 ra[16], rb[16]; \
            XDesc da = xdesc(it < I_X2 ? it : 0, p.w_gu, p.w_down, WguT, WdT), db = da; \
            if (it < I_X2) xload(da, ra, lane); \
            while (it < I_X2) { \
                const int nit = it + NGW; \
                if (nit < I_X2) { db = xdesc(nit, p.w_gu, p.w_down, WguT, WdT); xload(db, rb, lane); } \
                xstore(da, ra, 32.0f, xscr, lane); \
                da = db; \
                _Pragma("unroll") for (int i = 0; i < 16; ++i) ra[i] = rb[i]; \
                it = nit; \
            } } __syncthreads(); } while (0)
    const int wdpos = (bid >> 3) & 3;
    if (wdpos == 0) WD_CONVERT();
    na_attn_phase(L, projb, p.rel_bias, ycr, pss, bid, G);
    if (wdpos == 1) WD_CONVERT();
    mem_attn_phase(L, projb, kmem, vmem, ycr, pss, bid, G);
    if (wdpos == 2) WD_CONVERT();

    ft_stage1_phase(L, projb, Mid, tabC, tabS, tabSn, tab8192, bid, G);
    if (wdpos == 3) WD_CONVERT();
#undef WD_CONVERT
    xcd_barrier(bar);

    ft_stage2_phase(L, Mid, ycr, tab2, pss2, bid, G);
    xcd_barrier(bar);

    {
        PHASE_IDS
        pg8::Gemm g{ycr, WoutT, MIXW}; pg8::GroupOrder S; S.init(T / 256, 4, 8, G, bid, nullptr, nullptr);
        LAS float* rq = (LAS float*)(L + LDS_CTRL + 4096);
        for (int idx = tid; idx < 2 * 256; idx += NTH) {
            const int i = idx >> 8, r = idx & 255; pg8::Unit u;
            if (S.next(i, u)) {
                const size_t row = (size_t)u.pm * 256 + r;
                const float4 a0 = *(const float4*)(pss + row * 12), a1 = *(const float4*)(pss + row * 12 + 4), a2 = *(const float4*)(pss + row * 12 + 8);
                const float s_na = (a0.x + a0.y) + (a0.z + a0.w) + (a1.x + a1.y) + (a1.z + a1.w), s_mem = (a2.x + a2.y) + (a2.z + a2.w), s_ft = pss2[row];
                const float r_na = 1.0f / sqrtf(s_na * (1.0f / 512.0f) + 1e-6f), r_ft = 1.0f / sqrtf(s_ft * (1.0f / 512.0f) + 1e-6f), r_mem = 1.0f / sqrtf(s_mem * (1.0f / 512.0f) + 1e-6f);
                rq[idx * 4 + 0] = r_na / r_ft; rq[idx * 4 + 1] = r_ft / r_mem; rq[idx * 4 + 2] = r_mem;
            }
        }
        __syncthreads();
        pg8::EpiResBf16 E{p.x, x1b, rq};
        pg8::SideGu SD{p.w_gu, WguT, 80, 48, bid};
        pg8::gemm_phase<pg8::EpiResBf16, pg8::GroupOrder, false, false, pg8::SideGu>(L, idxbuf, g, S, E, SD);
    }
    xcd_barrier(bar);

    {
        PHASE_IDS
        const int fr = lane & 15, g4 = lane >> 4;
        constexpr int RW_PITCH = 2064;
        {
            const u32x4_t* sh = (const u32x4_t*)RwH; const u32x4_t* sl = (const u32x4_t*)RwL;
#pragma unroll
            for (int i = 0; i < 8; ++i) { const int pc = tid + 512 * i, row = pc >> 7, ch = pc & 127;
                *(LAS u32x4_t*)(L + row * RW_PITCH + ch * 16) = sh[pc]; *(LAS u32x4_t*)(L + (32 + row) * RW_PITCH + ch * 16) = sl[pc]; }
        }
        LAS unsigned* lcnt = (LAS unsigned*)(L + 64 * RW_PITCH);
        if (tid < 32) lcnt[tid] = 0u;
        __syncthreads();
        for (int tl = bid * 8 + wave; tl < T / 16; tl += G * 8) {
            const int tok = 16 * tl + fr;
            const bf16* xr = x1b + (size_t)tok * D + 8 * g4; unsigned char* hr = h8 + (size_t)tok * D + 8 * g4;
            const float* gp = p.g_ffn + 8 * g4;
            const LAS unsigned char* w0h = L + fr * RW_PITCH + 16 * g4; const LAS unsigned char* w1h = w0h + 16 * RW_PITCH; const LAS unsigned char* w0l = w0h + 32 * RW_PITCH; const LAS unsigned char* w1l = w0h + 48 * RW_PITCH;
            f32x4 acc0 = {0.f, 0.f, 0.f, 0.f}, acc1 = {0.f, 0.f, 0.f, 0.f}; float ssq = 0.f;
#pragma unroll 8
            for (int kc = 0; kc < 32; ++kc) {
                const u32x4_t xw = __builtin_nontemporal_load((const u32x4_t*)(xr + 32 * kc));
                const float4 a = make_float4(__builtin_bit_cast(float, xw.x << 16), __builtin_bit_cast(float, xw.x & 0xffff0000u), __builtin_bit_cast(float, xw.y << 16), __builtin_bit_cast(float, xw.y & 0xffff0000u));
                const float4 b = make_float4(__builtin_bit_cast(float, xw.z << 16), __builtin_bit_cast(float, xw.z & 0xffff0000u), __builtin_bit_cast(float, xw.w << 16), __builtin_bit_cast(float, xw.w & 0xffff0000u));
                const float4 ga = *(const float4*)(gp + 32 * kc), gb = *(const float4*)(gp + 32 * kc + 4);
                ssq += (a.x * a.x + a.y * a.y) + (a.z * a.z + a.w * a.w) + (b.x * b.x + b.y * b.y) + (b.z * b.z + b.w * b.w);
                const float h0 = a.x * ga.x, h1 = a.y * ga.y, h2v = a.z * ga.z, h3 = a.w * ga.w, h4 = b.x * gb.x, h5 = b.y * gb.y, h6 = b.z * gb.z, h7 = b.w * gb.w;
                u32x4_t hi; hi.x = pkbf(h0, h1); hi.y = pkbf(h2v, h3); hi.z = pkbf(h4, h5); hi.w = pkbf(h6, h7);
                u32x4_t lo;
                lo.x = pkbf(h0 - __builtin_bit_cast(float, hi.x << 16), h1 - __builtin_bit_cast(float, hi.x & 0xffff0000u));
                lo.y = pkbf(h2v - __builtin_bit_cast(float, hi.y << 16), h3 - __builtin_bit_cast(float, hi.y & 0xffff0000u));
                lo.z = pkbf(h4 - __builtin_bit_cast(float, hi.z << 16), h5 - __builtin_bit_cast(float, hi.z & 0xffff0000u));
                lo.w = pkbf(h6 - __builtin_bit_cast(float, hi.w << 16), h7 - __builtin_bit_cast(float, hi.w & 0xffff0000u));
                *(uint2*)(hr + 32 * kc) = make_uint2(pk_fp8x4(h0, h1, h2v, h3), pk_fp8x4(h4, h5, h6, h7));
                const bf16x8 hh = __builtin_bit_cast(bf16x8, hi), hl = __builtin_bit_cast(bf16x8, lo);
                const bf16x8 a0h = *(const LAS bf16x8*)(w0h + 64 * kc), a1h = *(const LAS bf16x8*)(w1h + 64 * kc), a0l = *(const LAS bf16x8*)(w0l + 64 * kc), a1l = *(const LAS bf16x8*)(w1l + 64 * kc);
                acc0 = MFMA16(a0h, hh, acc0); acc0 = MFMA16(a0l, hh, acc0); acc0 = MFMA16(a0h, hl, acc0);
                acc1 = MFMA16(a1h, hh, acc1); acc1 = MFMA16(a1l, hh, acc1); acc1 = MFMA16(a1h, hl, acc1);
            }
            ssq += __shfl_xor(ssq, 16); ssq += __shfl_xor(ssq, 32);
            const float rs = 1.0f / sqrtf(ssq * (1.0f / 1024.0f) + 1e-6f);
            const float4 rb0 = *(const float4*)(p.router_b + 4 * g4), rb1 = *(const float4*)(p.router_b + 16 + 4 * g4);
            float lv[8] = {acc0[0] * rs + rb0.x, acc0[1] * rs + rb0.y, acc0[2] * rs + rb0.z, acc0[3] * rs + rb0.w, acc1[0] * rs + rb1.x, acc1[1] * rs + rb1.y, acc1[2] * rs + rb1.z, acc1[3] * rs + rb1.w};
            float tv[4]; int ti[4];
#pragma unroll
            for (int k = 0; k < 4; ++k) {
                float bv = -3.0e38f; int bi = 0;
#pragma unroll
                for (int j = 0; j < 8; ++j) { const int ej = (j < 4 ? 4 * g4 + j : 16 + 4 * g4 + (j - 4)); if (lv[j] > bv) { bv = lv[j]; bi = ej; } }
#pragma unroll
                for (int o = 16; o <= 32; o <<= 1) { const float ov = __shfl_xor(bv, o); const int oi = __shfl_xor(bi, o); if (ov > bv || (ov == bv && oi < bi)) { bv = ov; bi = oi; } }
                tv[k] = bv; ti[k] = bi;
#pragma unroll
                for (int j = 0; j < 8; ++j) { const int ej = (j < 4 ? 4 * g4 + j : 16 + 4 * g4 + (j - 4)); if (ej == bi) lv[j] = -3.0e38f; }
            }
            const float e1 = expf(tv[1] - tv[0]), e2 = expf(tv[2] - tv[0]), e3 = expf(tv[3] - tv[0]);
            const float inv = 1.0f / (1.0f + e1 + e2 + e3);
            if (g4 == 0) {
                int4 ps;
                ps.x = (int)__hip_atomic_fetch_add(lcnt + ti[0], 1u, __ATOMIC_RELAXED, __HIP_MEMORY_SCOPE_WORKGROUP);
                ps.y = (int)__hip_atomic_fetch_add(lcnt + ti[1], 1u, __ATOMIC_RELAXED, __HIP_MEMORY_SCOPE_WORKGROUP);
                ps.z = (int)__hip_atomic_fetch_add(lcnt + ti[2], 1u, __ATOMIC_RELAXED, __HIP_MEMORY_SCOPE_WORKGROUP);
                ps.w = (int)__hip_atomic_fetch_add(lcnt + ti[3], 1u, __ATOMIC_RELAXED, __HIP_MEMORY_SCOPE_WORKGROUP);
                *(int4*)(tok_e + tok * 4) = make_int4(ti[0], ti[1], ti[2], ti[3]);
                *(float4*)(tok_g + tok * 4) = make_float4(inv, e1 * inv, e2 * inv, e3 * inv);
                *(int4*)(tok_pos + tok * 4) = ps;
                rsbuf[tok] = rs;
            }
        }
        __syncthreads();
        if (tid < 32) bbase[bid * 32 + tid] = atomicAdd(&ctl[CW_CNT + tid * 64], lcnt[tid]);
    }
    xcd_barrier(bar);

    {
        PHASE_IDS
        if (tid == 0) {
            int run = 0;
            for (int e = 0; e < 32; ++e) { const int c = (int)xb_ld(&ctl[CW_CNT + e * 64]); scnt[e] = c; sbase[e] = run; const int nt_e = (c + 255) / 256; for (int q = 0; q < nt_e; ++q) tile_e[run / 256 + q] = e; run += nt_e * 256; }
            sbase[32] = run;
        }
        __syncthreads();
        for (int i = bid * NTH + tid; i < MAXSLOT; i += G * NTH) ident[i] = i;
        for (int i = bid * NTH + tid; i < T * 4; i += G * NTH) {
            const int e = tok_e[i], blk = ((i >> 6) >> 3) % G, slot = sbase[e] + (int)bbase[blk * 32 + e] + tok_pos[i];
            slot_tok[slot] = i >> 2; slot_gate[slot] = tok_g[i]; slot_rs[slot] = rsbuf[i >> 2]; tok_slot[i] = slot;
        }
        if (bid < 32) { const int e = bid; for (int q = scnt[e] + tid; q < sbase[e + 1] - sbase[e]; q += NTH) { slot_tok[sbase[e] + q] = 0; slot_gate[sbase[e] + q] = 0.f; slot_rs[sbase[e] + q] = 0.f; } }
    }
    xcd_barrier(bar);

    const int ntm = sbase[32] / 256;
    {
        PHASE_IDS
        pg8::Gemm g{(const bf16*)h8, (const bf16*)WguT, 512}; pg8::GroupOrder S; S.init(ntm, 8, 4, G, bid, tile_e, slot_tok);
        pg8::EpiSwiglu E{act, p.b_gu, slot_rs, 1.0f / 32.0f};
        pg8::gemm_phase<pg8::EpiSwiglu, pg8::GroupOrder, true, true>(L, idxbuf, g, S, E);
    }
    xcd_barrier(bar);

    {
        PHASE_IDS
        pg8::Gemm g{(const bf16*)act, (const bf16*)WdT, 512}; pg8::GroupOrder S; S.init(ntm, 4, 8, G, bid, tile_e, ident); S.rev = 1;
        pg8::EpiDown E{Yb, p.b_down, slot_gate, 1.0f / 32.0f};
        pg8::gemm_phase<pg8::EpiDown, pg8::GroupOrder, true, true>(L, idxbuf, g, S, E);
    }
    xcd_barrier(bar);

    {
        PHASE_IDS
        for (int tok = bid * 8 + wave; tok < T; tok += G * 8) {
            float4 v[4]; float s = 0.f;
            const int4 sl4 = *(const int4*)(tok_slot + tok * 4);
            const int sl[4] = {sl4.x, sl4.y, sl4.z, sl4.w};
            uint2 xw[4]; unsigned yw[4][4];
#pragma unroll
            for (int j = 0; j < 4; ++j) { { const ntu2 t_ = __builtin_nontemporal_load((const ntu2*)(x1b + (size_t)tok * D) + lane + 64 * j); xw[j] = make_uint2(t_[0], t_[1]); }
#pragma unroll
                for (int q = 0; q < 4; ++q) yw[q][j] = __builtin_nontemporal_load((const unsigned*)(Yb + (size_t)sl[q] * 1024) + lane + 64 * j); }
#pragma unroll
            for (int j = 0; j < 4; ++j) {
                float ax = 0.f, ay = 0.f, az = 0.f, aw = 0.f;
#pragma unroll
                for (int q = 0; q < 4; ++q) { const f32x2_t lo = __builtin_amdgcn_cvt_pk_f32_fp8((int)yw[q][j], false), hi = __builtin_amdgcn_cvt_pk_f32_fp8((int)yw[q][j], true); ax += lo[0]; ay += lo[1]; az += hi[0]; aw += hi[1]; }
                v[j].x = __builtin_bit_cast(float, xw[j].x << 16) + ax * 0.0625f; v[j].y = __builtin_bit_cast(float, xw[j].x & 0xffff0000u) + ay * 0.0625f;
                v[j].z = __builtin_bit_cast(float, xw[j].y << 16) + az * 0.0625f; v[j].w = __builtin_bit_cast(float, xw[j].y & 0xffff0000u) + aw * 0.0625f;
                s += v[j].x * v[j].x + v[j].y * v[j].y + v[j].z * v[j].z + v[j].w * v[j].w;
            }
            s = wave_sum(s);
            const float rs = 1.0f / sqrtf(s * (1.0f / 1024.0f) + 1e-6f);
#pragma unroll
            for (int j = 0; j < 4; ++j) { const float4 gg = ((const float4*)p.g_final)[lane + 64 * j];
                v[j].x *= rs * gg.x; v[j].y *= rs * gg.y; v[j].z *= rs * gg.z; v[j].w *= rs * gg.w; __builtin_nontemporal_store((ntf4){v[j].x, v[j].y, v[j].z, v[j].w}, (ntf4*)(p.out + (size_t)tok * D) + lane + 64 * j); }
        }
    }
}

extern "C" void kernel_launch(void* const* d_in, const int* in_sizes, int n_in, void* d_out, int out_size, void* d_ws, size_t ws_size, hipStream_t stream) {
    static int grid = 0;
    if (grid == 0) {
        if (n_in != 17 || in_sizes[0] != T * D || out_size != T * D || ws_size < WS_END) { fprintf(stderr, "kernel_launch: unexpected shapes n_in %d in0 %d out %d ws %zu\n", n_in, n_in > 0 ? in_sizes[0] : -1, out_size, ws_size); grid = -1; return; }
        int dev = 0, cus = 0, per_cu = 0;
        if (hipGetDevice(&dev) != hipSuccess || hipDeviceGetAttribute(&cus, hipDeviceAttributeMultiprocessorCount, dev) != hipSuccess) { grid = -1; return; }
        if (hipFuncSetAttribute((const void*)mk_fwd, hipFuncAttributeMaxDynamicSharedMemorySize, LDS_BYTES) != hipSuccess) { fprintf(stderr, "kernel_launch: hipFuncSetAttribute failed\n"); grid = -1; return; }
        if (hipOccupancyMaxActiveBlocksPerMultiprocessor(&per_cu, (const void*)mk_fwd, NTH, LDS_BYTES) != hipSuccess || per_cu < 1) fprintf(stderr, "kernel_launch: occupancy query says %d\n", per_cu);
        (void)hipGetLastError();
        if (cus != 256) { fprintf(stderr, "kernel_launch: %d CUs (256 expected)\n", cus); grid = -1; return; }
        grid = cus;
    }
    if (grid < 0) return;
    if (hipMemsetAsync((char*)d_ws + WS_CTL, 0, CTL_ZERO_BYTES, stream) != hipSuccess) return;
    Params p{};
    p.x = (const float*)d_in[0]; p.mem = (const float*)d_in[1]; p.g_mix = (const float*)d_in[2]; p.g_mem = (const float*)d_in[3]; p.w_in = (const float*)d_in[4];
    p.w_mem_kv = (const float*)d_in[5]; p.rel_bias = (const float*)d_in[6]; p.g_grp = (const float*)d_in[7]; p.w_out = (const float*)d_in[8]; p.g_ffn = (const float*)d_in[9];
    p.router_w = (const float*)d_in[10]; p.router_b = (const float*)d_in[11]; p.w_gu = (const float*)d_in[12]; p.b_gu = (const float*)d_in[13]; p.w_down = (const float*)d_in[14];
    p.b_down = (const float*)d_in[15]; p.g_final = (const float*)d_in[16]; p.out = (float*)d_out; p.ws = (unsigned char*)d_ws;
    hipLaunchKernelGGL(mk_fwd, dim3(grid), dim3(NTH), LDS_BYTES, stream, p);
}
```

```cpp
#include <hip/hip_runtime.h>
#include <cstdio>
#include <cstdint>

#define LAS __attribute__((address_space(3)))

#define XB_TMO      128
#define XB_XCNT(j)  (256  + 64 * (j))
#define XB_XSUB(j)  (1280 + 64 * (j))
#define XB_XGEN(j)  (2304 + 64 * (j))
#define XB_TOP      3328
#define XB_TOPGEN   3392
#define XCD_BAR_WORDS 3456
#define XB_SPIN_CAP (1u << 22)

__device__ __forceinline__ unsigned xb_ld(unsigned* p)              { return __hip_atomic_load(p, __ATOMIC_RELAXED, __HIP_MEMORY_SCOPE_AGENT); }
__device__ __forceinline__ unsigned xb_add(unsigned* p, unsigned v) { return __hip_atomic_fetch_add(p, v, __ATOMIC_RELAXED, __HIP_MEMORY_SCOPE_AGENT); }
__device__ __forceinline__ unsigned xb_xcc_id() { return (unsigned)__builtin_amdgcn_s_getreg((3 << 11) | 20) & 0xFu; }
#define XB_SPIN(cond, bar) do { unsigned _sp = 0; while (cond) { __builtin_amdgcn_s_sleep(1); \
    if ((++_sp & 255u) == 0u) { if (xb_ld(&(bar)[XB_TMO])) break; if (_sp > XB_SPIN_CAP) { atomicAdd(&(bar)[XB_TMO], 1u); break; } } } } while (0)

struct XcdBarrier { unsigned* bar; unsigned x; volatile LAS unsigned* st; };

__device__ __forceinline__ XcdBarrier xcd_barrier_post(unsigned* bar, volatile LAS unsigned* st) {
    XcdBarrier b; b.bar = bar; b.x = xb_xcc_id(); b.st = st;
    if (threadIdx.x == 0) (void)xb_add(&bar[XB_XCNT(b.x)], 1u);
    return b;
}
__device__ __forceinline__ void xcd_barrier_complete(unsigned* bar, unsigned x, unsigned& nloc, unsigned& nx) {
    const unsigned G = gridDim.x * gridDim.y * gridDim.z;
    unsigned sum, cnt, mine, sp = 0u;
    for (;;) {
        sum = 0u; cnt = 0u; mine = 0u;
#pragma unroll
        for (unsigned j = 0; j < 16; ++j) { const unsigned c = xb_ld(&bar[XB_XCNT(j)]); sum += c; cnt += (c > 0u) ? 1u : 0u; mine = (j == x) ? c : mine; }
        if (sum == G) break;
        __builtin_amdgcn_s_sleep(1);
        if ((++sp & 255u) == 0u) { if (xb_ld(&bar[XB_TMO])) break; if (sp > XB_SPIN_CAP) { atomicAdd(&bar[XB_TMO], 1u); break; } }
    }
    nloc = mine > 0u ? mine : 1u; nx = cnt > 0u ? cnt : 1u;
}
__device__ __forceinline__ void xcd_barrier(const XcdBarrier& b) {
    asm volatile("s_waitcnt vmcnt(0)" ::: "memory");
    __syncthreads();
    if (threadIdx.x == 0) {
        unsigned* bar = b.bar;
        __builtin_amdgcn_s_waitcnt(0);
        unsigned nloc = b.st[0], nx = b.st[1];
        if (nloc == 0u) { xcd_barrier_complete(bar, b.x, nloc, nx); b.st[0] = nloc; b.st[1] = nx; }
        const unsigned old = xb_add(&bar[XB_XSUB(b.x)], 1u);
        const unsigned gen = old / nloc;
        asm volatile("buffer_inv sc1" ::: "memory");
        if (old + 1u == (gen + 1u) * nloc) {
            __builtin_amdgcn_fence(__ATOMIC_RELEASE, "agent");
            asm volatile("s_waitcnt vmcnt(0)" ::: "memory");
            const unsigned og = xb_add(&bar[XB_TOP], 1u);
            const unsigned tg = og / nx;
            if (og + 1u == (tg + 1u) * nx) xb_add(&bar[XB_TOPGEN], 1u);
            else XB_SPIN(xb_ld(&bar[XB_TOPGEN]) == tg, bar);
            asm volatile("" ::: "memory");
            xb_add(&bar[XB_XGEN(b.x)], 1u);
            asm volatile("s_waitcnt vmcnt(0)" ::: "memory");
        } else {
            XB_SPIN(xb_ld(&bar[XB_XGEN(b.x)]) == gen, bar);
            asm volatile("" ::: "memory");
            asm volatile("s_waitcnt vmcnt(0)" ::: "memory");
        }
    }
    __syncthreads();
}

constexpr int T = 32768, D = 1024, SEQ = 8192, INW = 2560, MIXW = 1536, NE = 32;
constexpr int NTH = 512;
constexpr int LDS_BYTES = 163840;
constexpr int MAXSLOT = 131072 + 32 * 256;
constexpr int LDS_CTRL = 151552;
constexpr int LDS_XBW = LDS_CTRL;
constexpr int LDS_SBASE = LDS_CTRL + 64;
constexpr int LDS_TILEE = LDS_CTRL + 512;
constexpr int LDS_IDX = LDS_CTRL + 4096;

constexpr size_t MiB = 1u << 20;
constexpr size_t WS_CTL = 0, CTL_ZERO_BYTES = 32 * 1024;
constexpr int CW_CNT = 0, CW_BAR = 4096, CW_TMO = 7936, CW_RDY = 8192;
constexpr size_t WS_TAB128 = 1 * MiB, WS_TAB64 = WS_TAB128 + 4096, WS_TAB8192 = WS_TAB128 + 8192;
constexpr size_t WS_MEMN = 2 * MiB;
constexpr size_t WS_WKV = 4 * MiB;
constexpr size_t WS_KMEM = 6 * MiB, WS_VMEM = 7 * MiB;
constexpr size_t WS_TOKE = 10 * MiB, WS_TOKG = WS_TOKE + 512 * 1024, WS_TOKPOS = 11 * MiB, WS_TOKSLOT = WS_TOKPOS + 512 * 1024;
constexpr size_t WS_SLOTTOK = 12 * MiB, WS_SLOTGATE = 13 * MiB;
constexpr size_t WS_TABC = 1 * MiB + 128 * 1024, WS_TABS = WS_TABC + 32 * 1024, WS_TABSN = WS_TABS + 32 * 1024, WS_TAB2 = WS_TABSN + 32 * 1024;
constexpr size_t WS_RWH = 1 * MiB + 256 * 1024, WS_RWL = WS_RWH + 64 * 1024;
constexpr size_t WS_PSS = 18 * MiB;
constexpr size_t WS_PSS2 = 20 * MiB;
constexpr size_t WS_IDENT = 16 * MiB;
constexpr size_t WS_BBASE = 14 * MiB, WS_RSBUF = 14 * MiB + 64 * 1024, WS_SLOTRS = 15 * MiB;
constexpr size_t WS_WIN = 32 * MiB;
constexpr size_t WS_WOUT = 40 * MiB;
constexpr size_t WS_WGU = 48 * MiB;
constexpr size_t WS_WD = 176 * MiB;
constexpr size_t WS_H8 = 208 * MiB;
constexpr size_t WS_HB = 240 * MiB;
constexpr size_t WS_PROJ = 304 * MiB;
constexpr size_t WS_V = 432 * MiB;
constexpr size_t WS_MID = 496 * MiB;
constexpr size_t WS_YCAT = 560 * MiB;
constexpr size_t WS_Y = 576 * MiB;
constexpr size_t WS_YCATN = 656 * MiB;
constexpr size_t WS_END = 848 * MiB;
constexpr int PW = 2560;

struct Params {
    const float *x, *mem, *g_mix, *g_mem, *w_in, *w_mem_kv, *rel_bias, *g_grp, *w_out, *g_ffn, *router_w, *router_b, *w_gu, *b_gu, *w_down, *b_down, *g_final;
    float* out; unsigned char* ws;
};

typedef unsigned short bf16;
typedef float ntf4 __attribute__((ext_vector_type(4)));
typedef unsigned ntu4 __attribute__((ext_vector_type(4)));
typedef unsigned ntu2 __attribute__((ext_vector_type(2)));
__device__ __forceinline__ float4 ld_nt_f4(const float* p) { const ntf4 t = __builtin_nontemporal_load((const ntf4*)p); return make_float4(t[0], t[1], t[2], t[3]); }
__device__ __forceinline__ unsigned f2bf(float f) { unsigned u = __builtin_bit_cast(unsigned, f); return (u + 0x7fffu + ((u >> 16) & 1u)) >> 16; }
__device__ __forceinline__ unsigned pk2(float lo, float hi) { return f2bf(lo) | (f2bf(hi) << 16); }
typedef float f32x2_t __attribute__((ext_vector_type(2)));
typedef __bf16 bf16x2_t __attribute__((ext_vector_type(2)));
__device__ __forceinline__ unsigned pkbf(float a, float b) { f32x2_t v = {a, b}; bf16x2_t r = __builtin_convertvector(v, bf16x2_t); return __builtin_bit_cast(unsigned, r); }
__device__ __forceinline__ float bf2f(bf16 b) { return __builtin_bit_cast(float, ((unsigned)b) << 16); }
__device__ __forceinline__ float wave_sum(float v) {
#pragma unroll
    for (int o = 1; o < 64; o <<= 1) v += __shfl_xor(v, o);
    return v;
}
__device__ __forceinline__ float wave_max(float v) {
#pragma unroll
    for (int o = 1; o < 64; o <<= 1) v = fmaxf(v, __shfl_xor(v, o));
    return v;
}

namespace pg8 {
#define PG8_LAS __attribute__((address_space(3)))
typedef unsigned short bf16_t;
typedef short bf16x8 __attribute__((ext_vector_type(8)));
typedef float f32x4 __attribute__((ext_vector_type(4)));
typedef unsigned u32x4 __attribute__((ext_vector_type(4)));
typedef unsigned u32x2 __attribute__((ext_vector_type(2)));
constexpr int BM = 256, BK = 64, HALF = 128, HTB = HALF * BK * 2, STAGE_BYTES = 8 * HTB;

__host__ __device__ __forceinline__ int lds_byte(int r, int c) { const int st = (r >> 4) * 2 + (c >> 5), rr = r & 15, cc = c & 31, ob = rr * 64 + cc * 2; return st * 1024 + (ob ^ (((ob >> 9) & 1) << 5)); }
__host__ __device__ __forceinline__ void stage_rc(int b, int& R, int& C) { const int st = b / 1024, sb = b % 1024, swz = sb ^ (((sb >> 9) & 1) << 5); R = (st >> 1) * 16 + swz / 64; C = (st & 1) * 32 + (swz % 64) / 2; }
__host__ __device__ __forceinline__ int perm32(int rho) { const int n = rho >> 4, i = rho & 15; return 8 * (i >> 2) + 4 * n + (i & 3); }

struct Unit { int pm, pn, e, pl; };
struct Gemm { const bf16_t* A; const bf16_t* Bt; int K; };

typedef int i32x4 __attribute__((ext_vector_type(4)));
typedef int i32x8 __attribute__((ext_vector_type(8)));
__device__ __forceinline__ i32x8 cat8(const bf16x8 lo, const bf16x8 hi) { return __builtin_shufflevector(__builtin_bit_cast(i32x4, lo), __builtin_bit_cast(i32x4, hi), 0, 1, 2, 3, 4, 5, 6, 7); }
__device__ __forceinline__ unsigned cvt_pk_bf16(float lo, float hi) { unsigned r; asm volatile("v_cvt_pk_bf16_f32 %0, %1, %2" : "=v"(r) : "v"(lo), "v"(hi)); return r; }

struct GroupOrder {
    int ntm, nN, nunits, Q, xcd, j, W, RG, rev; const PG8_LAS int* tile_e; const int* rowidx;
    unsigned* ready; unsigned need; unsigned* tmo;
    __device__ void init(int ntm_, int nN_, int RG_, int G, int c, const PG8_LAS int* te, const int* ri) {
        ntm = ntm_; nN = nN_; RG = RG_; nunits = ntm * nN; tile_e = te; rowidx = ri; rev = 0; ready = nullptr; need = 0u; tmo = nullptr;
        if (G % 8 == 0) { xcd = c % 8; j = c / 8; W = G / 8; Q = (nunits + 7) / 8; } else { xcd = 0; j = c; W = G; Q = nunits; }
    }
    __device__ __forceinline__ bool next(int i, Unit& u) const {
        const int ii = i * W + j; if (ii >= Q) return false;
        int idx = xcd * Q + ii; if (idx >= nunits) return false;
        if (rev) { const int hi = (xcd * Q + Q < nunits ? xcd * Q + Q : nunits) - 1; idx = hi - ii; }
        const int nig = RG * nN, gid = idx / nig, fm = gid * RG, gsz = (ntm - fm) < RG ? (ntm - fm) : RG, rem = idx - gid * nig;
        u.pm = fm + rem % gsz; u.pl = rem / gsz; u.e = tile_e ? tile_e[u.pm] : 0; u.pn = u.e * nN + u.pl; return true;
    }
    __device__ __forceinline__ void a_ready(const Unit& u) const {
        if (need == 0u) return;
        if (threadIdx.x < 64) {
            const unsigned long long t0 = __builtin_amdgcn_s_memrealtime(); unsigned polls = 0;
            while ((unsigned)__builtin_amdgcn_readfirstlane(__hip_atomic_load(ready + 64 * u.pm, __ATOMIC_RELAXED, __HIP_MEMORY_SCOPE_AGENT)) < need) {
                if ((++polls & 255u) == 0u && __builtin_amdgcn_readfirstlane(__hip_atomic_load(tmo, __ATOMIC_RELAXED, __HIP_MEMORY_SCOPE_AGENT)) != 0u) break;
                if (__builtin_amdgcn_s_memrealtime() - t0 > 2000000ull) { if (threadIdx.x == 0) __hip_atomic_store(tmo, 1u, __ATOMIC_RELAXED, __HIP_MEMORY_SCOPE_AGENT); break; }
                __builtin_amdgcn_s_sleep(2); }
            __builtin_amdgcn_fence(__ATOMIC_ACQUIRE, "agent");
            asm volatile("s_waitcnt vmcnt(0)" ::: "memory");
        }
        asm volatile("" ::: "memory"); __builtin_amdgcn_s_barrier(); asm volatile("" ::: "memory");
    }
    __device__ __forceinline__ void a_probe(const Unit& u, unsigned& pv) const {
        if (need == 0u || threadIdx.x >= 64) return;
        const unsigned* a = ready + 64 * u.pm;
        asm volatile("global_load_dword %0, %1, off sc1\n\tbuffer_inv sc1" : "+v"(pv) : "v"(a) : "memory");
    }
    __device__ __forceinline__ void a_ready_next(const Unit& u, unsigned& pv) const {
        if (need == 0u) return;
        if (threadIdx.x < 64) { asm volatile("" : "+v"(pv));
        if ((unsigned)__builtin_amdgcn_readfirstlane(pv) < need) {
        const unsigned long long t0 = __builtin_amdgcn_s_memrealtime(); unsigned polls = 0;
        while ((unsigned)__builtin_amdgcn_readfirstlane(__hip_atomic_load(ready + 64 * u.pm, __ATOMIC_RELAXED, __HIP_MEMORY_SCOPE_AGENT)) < need) {
            if ((++polls & 255u) == 0u && __builtin_amdgcn_readfirstlane(__hip_atomic_load(tmo, __ATOMIC_RELAXED, __HIP_MEMORY_SCOPE_AGENT)) != 0u) break;
            if (__builtin_amdgcn_s_memrealtime() - t0 > 2000000ull) { if ((threadIdx.x & 63) == 0) __hip_atomic_store(tmo, 1u, __ATOMIC_RELAXED, __HIP_MEMORY_SCOPE_AGENT); break; }
            __builtin_amdgcn_s_sleep(2); }
        __builtin_amdgcn_fence(__ATOMIC_ACQUIRE, "agent");
        asm volatile("s_waitcnt vmcnt(0)" ::: "memory"); } }
        asm volatile("" ::: "memory"); __builtin_amdgcn_s_barrier(); asm volatile("" ::: "memory");
    }
    __device__ __forceinline__ void publish(int pm) const {
        if (ready != nullptr && need == 0u && (threadIdx.x & 63) == 0) __hip_atomic_fetch_add(ready + 64 * pm, 1u, __ATOMIC_RELAXED, __HIP_MEMORY_SCOPE_AGENT);
    }
    __device__ __forceinline__ void done(const Unit&) const {}
};

__device__ __forceinline__ unsigned pk_fp8x4(float a, float b, float c, float d) { int r = 0; r = __builtin_amdgcn_cvt_pk_fp8_f32(a, b, r, false); r = __builtin_amdgcn_cvt_pk_fp8_f32(c, d, r, true); return (unsigned)r; }
struct NoSide { static constexpr bool ON = false; };
struct SideGu { static constexpr bool ON = true; const float* W; unsigned char* WT; int first, count, bid; };
constexpr int SIDE_LDS = 131072, SIDE_WPITCH = 1040, SIDE_BUF = 8 * SIDE_WPITCH;
template <bool F8> struct FragSel { typedef bf16x8 type; };
template <> struct FragSel<true> { typedef i32x8 type; };
template <class Epi, class Sched, bool GATHER, bool FP8 = false, class Side = NoSide>
__device__ __forceinline__ void gemm_phase(PG8_LAS unsigned char* lds, PG8_LAS int* idxbuf, const Gemm g, const Sched& S, const Epi& E, const Side SD = Side()) {
    int tid = threadIdx.x; asm volatile("" : "+v"(tid));
    const int wid = __builtin_amdgcn_readfirstlane(tid >> 6), lane = tid & 63, wr = wid >> 2, wc = wid & 3, fr = lane & 15, fq = lane >> 4;
    const int K = g.K, nt = K / BK;
    unsigned voffB[2];
#pragma unroll
    for (int i = 0; i < 2; ++i) { int R, C; stage_rc(tid * 16 + i * 8192, R, C); const int Rb = Epi::PERM ? ((R & ~31) + perm32(R & 31)) : R;
        voffB[i] = (unsigned)(Rb * K + C) * 2u; }
    const size_t kstep = (size_t)(BK * 2);
    const size_t hstep = (size_t)HALF * K * 2;
    const size_t tstep = 2 * hstep;
    const unsigned ldsw = (unsigned)wid * 1024u;
    const int aoff = lds_byte(wr * 64 + fr, fq * 8), boff = lds_byte(wc * 32 + fr, fq * 8);
    const PG8_LAS unsigned char* ldsA = lds + aoff; const PG8_LAS unsigned char* ldsB = lds + 4 * HTB + boff;
    asm volatile("" : "+v"(ldsA), "+v"(ldsB));
#define PG8_SA(b, h) (((b) * 2 + (h)) * HTB)
#define PG8_SB(b, h) ((4 + (b) * 2 + (h)) * HTB)
#define PG8_STAGE(bufoff, gbase, voff) do { _Pragma("unroll") for (int _i = 0; _i < 2; ++_i) \
        __builtin_amdgcn_global_load_lds((const unsigned*)((const char*)(gbase) + (voff)[_i]), (PG8_LAS unsigned*)(lds + (bufoff) + ldsw + _i * 8192), 16, 0, 0); } while (0)
#define PG8_LDF(dst, base, off) do { if constexpr (FP8) { const i32x4 _lo = *(const PG8_LAS i32x4*)((base) + (off)), _hi = *(const PG8_LAS i32x4*)((base) + (off) + 1024); dst[0] = __builtin_shufflevector(_lo, _hi, 0, 1, 2, 3, 4, 5, 6, 7); } \
        else { _Pragma("unroll") for (int k = 0; k < 2; ++k) dst[k] = *(const PG8_LAS FragT*)((base) + (off) + k * 1024); } } while (0)
#define PG8_LDA(dst, b, h) do { _Pragma("unroll") for (int m = 0; m < 4; ++m) PG8_LDF(dst[m], ldsA, ((b) * 2 + (h)) * HTB + m * 2048); } while (0)
#define PG8_LDB(dst, b, h) do { _Pragma("unroll") for (int n = 0; n < 2; ++n) PG8_LDF(dst[n], ldsB, ((b) * 2 + (h)) * HTB + n * 2048); } while (0)
#define PG8_MMA(ai, bj, At, Bt) do { __builtin_amdgcn_s_setprio(1); _Pragma("unroll") for (int m = 0; m < 4; ++m) _Pragma("unroll") for (int n = 0; n < 2; ++n) { \
        if constexpr (FP8) acc[ai][bj][m][n] = __builtin_amdgcn_mfma_scale_f32_16x16x128_f8f6f4(Bt[n][0], At[m][0], acc[ai][bj][m][n], 0, 0, 0, 0, 0, 0); \
        else { _Pragma("unroll") for (int k = 0; k < 2; ++k) acc[ai][bj][m][n] = __builtin_amdgcn_mfma_f32_16x16x32_bf16(Bt[n][k], At[m][k], acc[ai][bj][m][n], 0, 0, 0); } } \
        __builtin_amdgcn_s_setprio(0); } while (0)
#define PG8_WAIT_VKR(rx) do { if (rx) asm volatile("s_waitcnt vmcnt(%0)" :: "n"((Side::ON ? 10 : 8) + Epi::NST) : "memory"); else PG8_WAIT_VK; } while (0)
#define PG8_WAIT_VK do { if constexpr (Side::ON) asm volatile("s_waitcnt vmcnt(10)" ::: "memory"); else asm volatile("s_waitcnt vmcnt(8)" ::: "memory"); } while (0)
#define PG8_SIDE_J(j) const int _J = SD.first + ((j) < SD.count ? (j) : SD.count - 1);
#define PG8_SIDE_DMA(j, par) do { if constexpr (Side::ON) { PG8_SIDE_J(j) \
        __builtin_amdgcn_global_load_lds((const unsigned*)(sd_src0 + ((size_t)_J << 21) + sd_lsrc), (PG8_LAS unsigned*)(lds + SIDE_LDS + (par) * SIDE_BUF + wid * SIDE_WPITCH), 16, 0, 2); } } while (0)
#define PG8_SIDE_RD(par) do { if constexpr (Side::ON) { const PG8_LAS unsigned char* _b = lds + SIDE_LDS + (par) * SIDE_BUF + sd_lrd; _Pragma("unroll") for (int _q = 0; _q < 4; ++_q) sdv[_q] = *(const PG8_LAS float*)(_b + _q * 128); } } while (0)
#define PG8_SIDE_ST(j) do { if constexpr (Side::ON) { PG8_SIDE_J(j) PG8_WAIT_L(0); \
        __builtin_nontemporal_store(pk_fp8x4(sdv[0] * 32.0f, sdv[1] * 32.0f, sdv[2] * 32.0f, sdv[3] * 32.0f), (unsigned*)(sd_dst0 + ((size_t)(_J >> 2) << 21) + (_J & 3) * 256 + sd_ldst)); } } while (0)
#define PG8_WAIT_V(n) asm volatile("s_waitcnt vmcnt(" #n ")" ::: "memory")
#define PG8_WAIT_L(n) asm volatile("s_waitcnt lgkmcnt(" #n ")" ::: "memory")
#define PG8_BAR __builtin_amdgcn_s_barrier()
#define PG8_SCHED __builtin_amdgcn_sched_barrier(0)
#define PG8_SETV(v, par) do { _Pragma("unroll") for (int _i = 0; _i < 2; ++_i) { int _R, _C; stage_rc(tid * 16 + _i * 8192, _R, _C); _Pragma("unroll") for (int _h = 0; _h < 2; ++_h) { \
        if constexpr (GATHER) v[_h][_i] = (unsigned)idxbuf[(par) * 256 + _h * 128 + _R] * (unsigned)(K * 2) + (unsigned)_C * 2u; \
        else v[_h][_i] = (unsigned)((_h * 128 + _R) * K) * 2u + (unsigned)_C * 2u; } } } while (0)
#define PG8_AUXDMA(u, par) do { if constexpr (Epi::AUX) { PG8_LAS float* _ax = (PG8_LAS float*)(idxbuf + 512) + (par) * 512; \
        if (wid >= 4) __builtin_amdgcn_global_load_lds((const unsigned*)(E.rowsrc(u) + (wid - 4) * 64 + lane), (PG8_LAS unsigned*)(_ax + (wid - 4) * 64), 4, 0, 0); \
        else __builtin_amdgcn_global_load_lds((const unsigned*)(E.colsrc(u, wid) + lane), (PG8_LAS unsigned*)(_ax + 256 + wid * 64), 4, 0, 0); } } while (0)
#define PG8_IDXDMA(u, par) do { if constexpr (GATHER) { if (wid < 4) \
        __builtin_amdgcn_global_load_lds((const unsigned*)(S.rowidx + (size_t)(u).pm * 256 + wid * 64 + lane), (PG8_LAS unsigned*)(idxbuf + (par) * 256 + wid * 64), 4, 0, 0); } } while (0)
    Unit cur, nxt; int ui = 0, ppm = -1; unsigned pv = 0u;
    if (!S.next(0, cur)) return;
    int sj = 0; float sdv[4];
    const unsigned sd_lsrc = (unsigned)((lane >> 3) * 8192 + (lane & 7) * 16), sd_lrd = (unsigned)(((lane & 15) >> 1) * SIDE_WPITCH + (lane & 1) * 512 + (4 * wid + (lane >> 4)) * 4), sd_ldst = (unsigned)((lane >> 4) * 1024 + 4 * (lane & 15));
    const char* sd_src0 = nullptr; unsigned char* sd_dst0 = nullptr;
    if constexpr (Side::ON) { const int nb = SD.bid & 63, kq = SD.bid >> 6;
        sd_src0 = (const char*)SD.W + (size_t)((kq * 64 + wid * 8) * 8192 + nb * 128);
        sd_dst0 = SD.WT + (size_t)((((nb >> 2) & 7) * 256 + (nb >> 5) * 128 + (nb & 3) * 32 + 4 * wid) * 1024 + kq * 64); }
    PG8_SIDE_DMA(0, 0);
    f32x4 acc[2][2][4][2];
#pragma unroll
    for (int a = 0; a < 2; ++a)
#pragma unroll
        for (int b = 0; b < 2; ++b)
#pragma unroll
            for (int m = 0; m < 4; ++m)
#pragma unroll
                for (int n = 0; n < 2; ++n) acc[a][b][m][n] = (f32x4){0.f, 0.f, 0.f, 0.f};
    typedef typename FragSel<FP8>::type FragT; constexpr int KF = FP8 ? 1 : 2;
    FragT At[4][KF], B0[2][KF], B1[2][KF];
    const char* cA = GATHER ? (const char*)g.A : (const char*)g.A + (size_t)cur.pm * tstep; const char* cB = (const char*)g.Bt + (size_t)cur.pn * tstep;
    unsigned cv[2][2], nv[2][2];
    if constexpr (GATHER) { PG8_STAGE(PG8_SB(0, 0), cB, voffB); PG8_STAGE(PG8_SB(0, 1), cB + hstep, voffB); PG8_STAGE(PG8_SB(1, 0), cB + kstep, voffB); PG8_STAGE(PG8_SB(1, 1), cB + hstep + kstep, voffB);
                            PG8_IDXDMA(cur, 0); PG8_WAIT_V(0); PG8_BAR; }
    PG8_SETV(cv, 0);
    S.a_ready(cur);
    if constexpr (GATHER) {
        PG8_STAGE(PG8_SA(0, 0), cA, cv[0]); PG8_STAGE(PG8_SA(0, 1), cA, cv[1]); PG8_STAGE(PG8_SA(1, 0), cA + kstep, cv[0]);
        if (wr == 1) PG8_BAR;
        PG8_WAIT_V(2); PG8_BAR; PG8_BAR;
    } else {
    PG8_STAGE(PG8_SB(0, 0), cB, voffB); PG8_STAGE(PG8_SB(0, 1), cB + hstep, voffB); PG8_STAGE(PG8_SA(0, 0), cA, cv[0]); PG8_STAGE(PG8_SA(0, 1), cA, cv[1]);
    PG8_STAGE(PG8_SB(1, 0), cB + kstep, voffB); PG8_STAGE(PG8_SA(1, 0), cA + kstep, cv[0]); PG8_STAGE(PG8_SB(1, 1), cB + hstep + kstep, voffB);
    if (wr == 1) PG8_BAR;
    PG8_WAIT_V(6); PG8_BAR; PG8_BAR;
    }
    for (;;) {
        const bool has_next = S.next(ui + 1, nxt);
        const char* nA = has_next ? (GATHER ? (const char*)g.A : (const char*)g.A + (size_t)nxt.pm * tstep) : cA; const char* nB = has_next ? (const char*)g.Bt + (size_t)nxt.pn * tstep : cB;
        if (has_next) PG8_IDXDMA(nxt, (ui + 1) & 1);
#pragma unroll
        for (int h = 0; h < 2; ++h)
#pragma unroll
            for (int i = 0; i < 2; ++i) nv[h][i] = cv[h][i];
#pragma unroll 1
        for (int t = 0; t < nt; t += 2) {
            const bool last = (t == nt - 2), relax = (t == 0) && (ui > 0) && (Epi::NST > 0);
            const char* a1 = cA + (size_t)(t + 1) * kstep;
            const char* a2 = last ? nA : cA + (size_t)(t + 2) * kstep; const char* b2 = last ? nB : cB + (size_t)(t + 2) * kstep;
            const char* a3 = a2 + kstep; const char* b3 = b2 + kstep;
            if (last && has_next) { S.a_ready_next(nxt, pv); PG8_SETV(nv, (ui + 1) & 1); }
            if constexpr (Epi::KSCALE) { if (t == 8 || t == 16) E.kscale(acc, ui, t == 8 ? 0 : 1, wr, fr); }
            if (t == 2 && ppm >= 0) { S.publish(ppm); ppm = -1; }
            if (t == 2 && has_next) S.a_probe(nxt, pv);
            if (t == 2) PG8_AUXDMA(cur, ui & 1);
            PG8_SIDE_DMA(sj + 1, 1); PG8_LDB(B0, 0, 0); PG8_LDB(B1, 0, 1); PG8_SCHED; PG8_LDA(At, 0, 0); PG8_STAGE(PG8_SA(1, 1), a1, cv[1]);
            if (last) {
#pragma unroll
                for (int h = 0; h < 2; ++h)
#pragma unroll
                    for (int i = 0; i < 2; ++i) cv[h][i] = nv[h][i]; }
            PG8_WAIT_VKR(relax); PG8_WAIT_L(0); PG8_BAR; PG8_MMA(0, 0, At, B0); PG8_MMA(0, 1, At, B1); PG8_BAR; PG8_SCHED;
            PG8_LDA(At, 0, 1); PG8_SIDE_RD(0); PG8_STAGE(PG8_SB(0, 0), b2, voffB); PG8_STAGE(PG8_SB(0, 1), b2 + hstep, voffB); PG8_STAGE(PG8_SA(0, 0), a2, cv[0]); PG8_SIDE_ST(sj);
            PG8_WAIT_VKR(relax); PG8_WAIT_L(0); PG8_BAR; PG8_MMA(1, 0, At, B0); PG8_MMA(1, 1, At, B1); PG8_BAR; PG8_SCHED;
            PG8_SIDE_DMA(sj + 2, 0); PG8_LDB(B0, 1, 0); PG8_LDB(B1, 1, 1); PG8_SCHED; PG8_LDA(At, 1, 0); PG8_STAGE(PG8_SA(0, 1), a2, cv[1]);
            PG8_WAIT_VK; PG8_WAIT_L(0); PG8_BAR; PG8_MMA(0, 0, At, B0); PG8_MMA(0, 1, At, B1); PG8_BAR; PG8_SCHED;
            PG8_LDA(At, 1, 1); PG8_SIDE_RD(1); PG8_STAGE(PG8_SB(1, 0), b3, voffB); PG8_STAGE(PG8_SB(1, 1), b3 + hstep, voffB); PG8_STAGE(PG8_SA(1, 0), a3, cv[0]); PG8_SIDE_ST(sj + 1);
            PG8_WAIT_VK; PG8_WAIT_L(0); PG8_BAR; PG8_MMA(1, 0, At, B0); PG8_MMA(1, 1, At, B1); PG8_BAR; PG8_SCHED;
            sj += 2;
        }
        if (wr == 0) PG8_BAR;
        E(acc, cur, wr, wc, fr, fq, (const PG8_LAS float*)(idxbuf + 512) + (ui & 1) * 512, ui); S.done(cur); ppm = cur.pm;
        if (!has_next) break;
#pragma unroll
        for (int a = 0; a < 2; ++a)
#pragma unroll
            for (int b = 0; b < 2; ++b)
#pragma unroll
                for (int m = 0; m < 4; ++m)
#pragma unroll
                    for (int n = 0; n < 2; ++n) acc[a][b][m][n] = (f32x4){0.f, 0.f, 0.f, 0.f};
        cur = nxt; cA = nA; cB = nB; ++ui;
        if (wr == 1) PG8_BAR;
    }
    PG8_WAIT_V(0);
    if (ppm >= 0) S.publish(ppm);
    PG8_BAR;
#undef PG8_SA
#undef PG8_WAIT_VK
#undef PG8_WAIT_VKR
#undef PG8_SIDE_J
#undef PG8_SIDE_DMA
#undef PG8_SIDE_RD
#undef PG8_SIDE_ST
#undef PG8_SB
#undef PG8_STAGE
#undef PG8_LDA
#undef PG8_LDF
#undef PG8_LDB
#undef PG8_MMA
#undef PG8_WAIT_V
#undef PG8_WAIT_L
#undef PG8_BAR
#undef PG8_SCHED
#undef PG8_SETV
#undef PG8_IDXDMA
#undef PG8_AUXDMA
}

struct EpiBf16Plain {
    static constexpr bool PERM = true, AUX = false, KSCALE = false; static constexpr int NST = 16;
    bf16_t* O; int ldc;
    __device__ __forceinline__ void operator()(const f32x4 (&acc)[2][2][4][2], const Unit& u, int wr, int wc, int fr, int fq, const PG8_LAS float* aux, int ui) const {
        const int row0 = u.pm * BM + wr * 64 + fr, col0 = u.pl * BM + wc * 32 + 8 * fq;
#pragma unroll
        for (int ai = 0; ai < 2; ++ai)
#pragma unroll
            for (int m = 0; m < 4; ++m) { bf16_t* rowp = O + (size_t)(row0 + ai * HALF + m * 16) * ldc + col0;
#pragma unroll
                for (int bj = 0; bj < 2; ++bj) { const f32x4 v0 = acc[ai][bj][m][0], v1 = acc[ai][bj][m][1];
                    u32x4 w; w.x = cvt_pk_bf16(v0[0], v0[1]); w.y = cvt_pk_bf16(v0[2], v0[3]); w.z = cvt_pk_bf16(v1[0], v1[1]); w.w = cvt_pk_bf16(v1[2], v1[3]);
                    *(u32x4*)(rowp + bj * HALF) = w; } }
    }
};
struct EpiProj3 {
    static constexpr bool PERM = true, AUX = false, KSCALE = false; static constexpr int NST = 0;
    bf16_t* P; bf16_t* V;
    __device__ __forceinline__ void operator()(const f32x4 (&acc)[2][2][4][2], const Unit& u, int wr, int wc, int fr, int fq, const PG8_LAS float* aux, int ui) const {
        const bool isv = (u.pl >= 6) && (u.pl < 10);
        bf16_t* O = isv ? V : P; const int ldc = isv ? 1024 : 2048;
        const int colt = u.pl < 6 ? u.pl * BM : (isv ? (u.pl - 6) * BM : 1536 + (u.pl - 10) * BM);
        const int row0 = u.pm * BM + wr * 64 + fr, col0 = colt + wc * 32 + 8 * fq;
#pragma unroll
        for (int ai = 0; ai < 2; ++ai)
#pragma unroll
            for (int m = 0; m < 4; ++m) { bf16_t* rowp = O + (size_t)(row0 + ai * HALF + m * 16) * ldc + col0;
#pragma unroll
                for (int bj = 0; bj < 2; ++bj) { const f32x4 v0 = acc[ai][bj][m][0], v1 = acc[ai][bj][m][1];
                    u32x4 w; w.x = cvt_pk_bf16(v0[0], v0[1]); w.y = cvt_pk_bf16(v0[2], v0[3]); w.z = cvt_pk_bf16(v1[0], v1[1]); w.w = cvt_pk_bf16(v1[2], v1[3]);
                    *(u32x4*)(rowp + bj * HALF) = w; } }
    }
};
struct EpiResBf16 {
    static constexpr bool PERM = true, AUX = false, KSCALE = true; static constexpr int NST = 16;
    const float* base; bf16_t* C; const PG8_LAS float* rq;
    __device__ __forceinline__ void kscale(f32x4 (&acc)[2][2][4][2], int ui, int which, int wr, int fr) const {
#pragma unroll
        for (int ai = 0; ai < 2; ++ai)
#pragma unroll
            for (int m = 0; m < 4; ++m) { const float q = rq[(ui * 256 + ai * HALF + wr * 64 + m * 16 + fr) * 4 + which];
#pragma unroll
                for (int bj = 0; bj < 2; ++bj)
#pragma unroll
                    for (int n = 0; n < 2; ++n) acc[ai][bj][m][n] = acc[ai][bj][m][n] * q; }
    }
    __device__ __forceinline__ void operator()(const f32x4 (&acc)[2][2][4][2], const Unit& u, int wr, int wc, int fr, int fq, const PG8_LAS float* aux, int ui) const {
        const int row0 = u.pm * BM + wr * 64 + fr, col0 = u.pl * BM + wc * 32 + 8 * fq;
#pragma unroll
        for (int ai = 0; ai < 2; ++ai)
#pragma unroll
            for (int m = 0; m < 4; ++m) { const size_t off = (size_t)(row0 + ai * HALF + m * 16) * 1024 + col0; const float q3 = rq[(ui * 256 + ai * HALF + wr * 64 + m * 16 + fr) * 4 + 2];
#pragma unroll
                for (int bj = 0; bj < 2; ++bj) { const f32x4 b0 = __builtin_nontemporal_load((const f32x4*)(base + off + bj * HALF)), b1 = __builtin_nontemporal_load((const f32x4*)(base + off + bj * HALF + 4));
                    const f32x4 v0 = b0 + acc[ai][bj][m][0] * q3, v1 = b1 + acc[ai][bj][m][1] * q3;
                    u32x4 w; w.x = cvt_pk_bf16(v0[0], v0[1]); w.y = cvt_pk_bf16(v0[2], v0[3]); w.z = cvt_pk_bf16(v1[0], v1[1]); w.w = cvt_pk_bf16(v1[2], v1[3]);
                    *(u32x4*)(C + off + bj * HALF) = w; }
                if (m & 1) asm volatile("" ::: "memory"); }
    }
};
typedef float f32x2 __attribute__((ext_vector_type(2)));
__device__ __forceinline__ f32x2 swiglu2(f32x2 g, f32x2 l) {
    g = __builtin_elementwise_min(g, (f32x2){7.0f, 7.0f});
    l = __builtin_elementwise_min(__builtin_elementwise_max(l, (f32x2){-6.0f, -6.0f}), (f32x2){8.0f, 8.0f});
    const f32x2 z = g * (-1.702f * 1.4426950408889634f);
    f32x2 t; t.x = __builtin_amdgcn_exp2f(z.x); t.y = __builtin_amdgcn_exp2f(z.y);
    const f32x2 d = t + 1.0f;
    f32x2 s; s.x = __builtin_amdgcn_rcpf(d.x); s.y = __builtin_amdgcn_rcpf(d.y);
    return (g * s) * l;
}
struct EpiSwiglu {
    static constexpr bool PERM = true, AUX = true, KSCALE = false; static constexpr int NST = 4;
    unsigned char* act; const float* b_gu; const float* rs; float wscale;
    __device__ __forceinline__ const float* rowsrc(const Unit& u) const { return rs + (size_t)u.pm * BM; }
    __device__ __forceinline__ const float* colsrc(const Unit& u, int w) const { return b_gu + (size_t)u.e * 2048 + (w >> 1) * 1024 + u.pl * HALF + (w & 1) * 64; }
    __device__ __forceinline__ void operator()(const f32x4 (&acc)[2][2][4][2], const Unit& u, int wr, int wc, int fr, int fq, const PG8_LAS float* aux, int ui) const {
        const int row0 = u.pm * BM + wr * 64 + fr, col0 = u.pl * HALF + wc * 32 + 8 * fq;
        const PG8_LAS float* bg = aux + 256 + wc * 32 + 8 * fq;
        const f32x4 g0 = *(const PG8_LAS f32x4*)(bg), g1 = *(const PG8_LAS f32x4*)(bg + 4), l0 = *(const PG8_LAS f32x4*)(bg + 128) + 1.0f, l1 = *(const PG8_LAS f32x4*)(bg + 132) + 1.0f;
#pragma unroll
        for (int ai = 0; ai < 2; ++ai)
#pragma unroll
            for (int mp = 0; mp < 2; ++mp) {
                unsigned w0[2], w1[2];
#pragma unroll
                for (int mm = 0; mm < 2; ++mm) { const int m = 2 * mp + mm;
                    const float r = aux[ai * HALF + wr * 64 + m * 16 + fr] * wscale;
                    const f32x4 a0 = acc[ai][0][m][0] * r + g0, a1 = acc[ai][0][m][1] * r + g1, b0 = acc[ai][1][m][0] * r + l0, b1 = acc[ai][1][m][1] * r + l1;
                    const f32x2 p0 = swiglu2((f32x2){a0[0], a0[1]}, (f32x2){b0[0], b0[1]}), p1 = swiglu2((f32x2){a0[2], a0[3]}, (f32x2){b0[2], b0[3]});
                    const f32x2 p2 = swiglu2((f32x2){a1[0], a1[1]}, (f32x2){b1[0], b1[1]}), p3 = swiglu2((f32x2){a1[2], a1[3]}, (f32x2){b1[2], b1[3]});
                    w0[mm] = pk_fp8x4(p0.x, p0.y, p1.x, p1.y); w1[mm] = pk_fp8x4(p2.x, p2.y, p3.x, p3.y); }
                const u32x2 s0 = __builtin_amdgcn_permlane16_swap(w0[0], w0[1], false, false), s1 = __builtin_amdgcn_permlane16_swap(w1[0], w1[1], false, false);
                const int row = row0 + ai * HALF + (2 * mp + (fq & 1)) * 16;
                { const u32x4 wv = (u32x4){s0[0], s1[0], s0[1], s1[1]}; unsigned char* wp = act + (size_t)row * 1024 + u.pl * HALF + wc * 32 + 16 * (fq >> 1);
                  *(u32x4*)wp = wv; } }
    }
};
struct EpiDown {
    static constexpr bool PERM = true, AUX = true, KSCALE = false; static constexpr int NST = 8;
    unsigned char* Y; const float* b_down; const float* gate; float wscale;
    __device__ __forceinline__ const float* rowsrc(const Unit& u) const { return gate + (size_t)u.pm * BM; }
    __device__ __forceinline__ const float* colsrc(const Unit& u, int w) const { return b_down + (size_t)u.e * 1024 + u.pl * BM + w * 64; }
    __device__ __forceinline__ void operator()(const f32x4 (&acc)[2][2][4][2], const Unit& u, int wr, int wc, int fr, int fq, const PG8_LAS float* aux, int ui) const {
        const int row0 = u.pm * BM + wr * 64 + fr, col0 = u.pl * BM + wc * 64 + 16 * fq;
        const PG8_LAS float* bd = aux + 256 + wc * 64 + 16 * fq;
        const f32x4 b00 = *(const PG8_LAS f32x4*)(bd) * 16.0f, b01 = *(const PG8_LAS f32x4*)(bd + 4) * 16.0f, b10 = *(const PG8_LAS f32x4*)(bd + 8) * 16.0f, b11 = *(const PG8_LAS f32x4*)(bd + 12) * 16.0f; const float ws16 = wscale * 16.0f;
#pragma unroll
        for (int ai = 0; ai < 2; ++ai)
#pragma unroll
            for (int m = 0; m < 4; ++m) { const int rl = ai * HALF + wr * 64 + m * 16 + fr;
                const f32x4 lim = {440.f, 440.f, 440.f, 440.f};
                const f32x4 v0 = __builtin_elementwise_min(__builtin_elementwise_max(acc[ai][0][m][0] * ws16 + b00, -lim), lim), v1 = __builtin_elementwise_min(__builtin_elementwise_max(acc[ai][0][m][1] * ws16 + b01, -lim), lim),
                            v2 = __builtin_elementwise_min(__builtin_elementwise_max(acc[ai][1][m][0] * ws16 + b10, -lim), lim), v3 = __builtin_elementwise_min(__builtin_elementwise_max(acc[ai][1][m][1] * ws16 + b11, -lim), lim);
                u32x4 w; w.x = pk_fp8x4(v0[0], v0[1], v0[2], v0[3]); w.y = pk_fp8x4(v1[0], v1[1], v1[2], v1[3]); w.z = pk_fp8x4(v2[0], v2[1], v2[2], v2[3]); w.w = pk_fp8x4(v3[0], v3[1], v3[2], v3[3]);
                *(u32x4*)(Y + (size_t)(u.pm * BM + rl) * 1024 + col0) = w; }
    }
};
}
using pg8::pk_fp8x4;

__device__ __forceinline__ void transpose_load(const float* W, int ldw, int k0, int n0, float scale, LAS float* scr, int lane, const float* rowscale = nullptr) {
    float4 r[8]; float rsc[8];
#pragma unroll
    for (int i = 0; i < 8; ++i) { r[i] = ld_nt_f4(W + (size_t)(k0 + 8 * i + (lane >> 3)) * ldw + n0 + 4 * (lane & 7)); rsc[i] = rowscale ? rowscale[k0 + 8 * i + (lane >> 3)] * scale : scale; }
#pragma unroll
    for (int i = 0; i < 8; ++i) { LAS float* d = scr + (8 * i + (lane >> 3)) * 33 + 4 * (lane & 7); d[0] = r[i].x * rsc[i]; d[1] = r[i].y * rsc[i]; d[2] = r[i].z * rsc[i]; d[3] = r[i].w * rsc[i]; }
    asm volatile("s_waitcnt lgkmcnt(0)" ::: "memory");
}
__device__ __forceinline__ void transpose_item(const float* W, int ldw, int K, bf16* WT, int rowbase, int k0, int n0, LAS float* scr, int lane, const float* rowscale = nullptr) {
    transpose_load(W, ldw, k0, n0, 1.0f, scr, lane, rowscale);
    const int c = lane & 7;
#pragma unroll
    for (int j = 0; j < 4; ++j) { const int n = (lane >> 3) + 8 * j; const LAS float* s = scr + (8 * c) * 33 + n;
        uint4 o; o.x = pkbf(s[0 * 33], s[1 * 33]); o.y = pkbf(s[2 * 33], s[3 * 33]); o.z = pkbf(s[4 * 33], s[5 * 33]); o.w = pkbf(s[6 * 33], s[7 * 33]);
        *(uint4*)(WT + (size_t)(rowbase + n) * K + k0 + 8 * c) = o; }
    asm volatile("s_waitcnt lgkmcnt(0)" ::: "memory");
}

__device__ __forceinline__ void transpose_item_fp8(const float* W, int ldw, int K, unsigned char* WT, int rowbase, int k0, int n0, float scale, LAS float* scr, int lane) {
    transpose_load(W, ldw, k0, n0, scale, scr, lane);
    const int c = lane & 7;
#pragma unroll
    for (int j = 0; j < 4; ++j) { const int n = (lane >> 3) + 8 * j; const LAS float* s = scr + (8 * c) * 33 + n;
        uint2 o; o.x = pk_fp8x4(s[0 * 33], s[1 * 33], s[2 * 33], s[3 * 33]); o.y = pk_fp8x4(s[4 * 33], s[5 * 33], s[6 * 33], s[7 * 33]);
        *(uint2*)(WT + (size_t)(rowbase + n) * K + k0 + 8 * c) = o; }
    asm volatile("s_waitcnt lgkmcnt(0)" ::: "memory");
}

struct XDesc { const float* W; unsigned char* WT; int ldw, rowbase, k0, n0, perm; };
__device__ __forceinline__ XDesc xdesc(int r, const float* w_gu, const float* w_down, unsigned char* WguT, unsigned char* WdT) {
    XDesc d;
    if (r < 16384) { const int e = r >> 9, q = r & 511, kb = q >> 6, nb = q & 63, n0 = nb * 32;
        d.W = w_gu + (size_t)e * 1024 * 2048; d.WT = WguT; d.ldw = 2048; d.k0 = kb * 128; d.n0 = n0;
        d.rowbase = e * 2048 + ((n0 & 1023) >> 7) * 256 + (n0 >> 10) * 128 + (n0 & 127); d.perm = 0; }
    else { const int r2 = r - 16384, e = r2 >> 8, q = r2 & 255, kb = q >> 5, nb = q & 31;
        d.W = w_down + (size_t)e * 1024 * 1024; d.WT = WdT; d.ldw = 1024; d.k0 = kb * 128; d.n0 = nb * 32; { const int c0 = (nb * 32) & 255; d.rowbase = e * 1024 + ((nb * 32) & ~255) + 32 * (c0 >> 6) + 8 * ((c0 >> 4) & 3); } d.perm = 1; }
    return d;
}
__device__ __forceinline__ void xload(const XDesc& d, float4 (&r)[16], int lane) {
#pragma unroll
    for (int i = 0; i < 16; ++i) { const pg8::f32x4 t_ = __builtin_nontemporal_load((const pg8::f32x4*)(d.W + (size_t)(d.k0 + 8 * i + (lane >> 3)) * d.ldw + d.n0 + 4 * (lane & 7))); r[i] = make_float4(t_[0], t_[1], t_[2], t_[3]); }
}
__device__ __forceinline__ void xstore(const XDesc& d, const float4 (&r)[16], float scale, LAS float* scr, int lane) {
#pragma unroll
    for (int i = 0; i < 16; ++i) { LAS float* o = scr + (8 * i + (lane >> 3)) * 33 + 4 * (lane & 7); o[0] = r[i].x * scale; o[1] = r[i].y * scale; o[2] = r[i].z * scale; o[3] = r[i].w * scale; }
    asm volatile("s_waitcnt lgkmcnt(0)" ::: "memory");
    const int c = lane & 15;
#pragma unroll
    for (int j = 0; j < 8; ++j) { const int n = (lane >> 4) + 4 * j; const LAS float* s = scr + (8 * c) * 33 + n;
        uint2 o; o.x = pk_fp8x4(s[0 * 33], s[1 * 33], s[2 * 33], s[3 * 33]); o.y = pk_fp8x4(s[4 * 33], s[5 * 33], s[6 * 33], s[7 * 33]);
        const int row = d.rowbase + (d.perm ? 128 * ((n >> 3) & 1) + 8 * (n >> 4) + (n & 7) : n);
        { typedef unsigned ntu2s __attribute__((ext_vector_type(2))); __builtin_nontemporal_store((ntu2s){o.x, o.y}, (ntu2s*)(d.WT + (size_t)row * 1024 + d.k0 + 8 * c)); } }
    asm volatile("s_waitcnt lgkmcnt(0)" ::: "memory");
}

__device__ __forceinline__ void rms_row_bf16(const float* xr, const float* g, bf16* o, int lane, float4 (&v)[4]) {
    float s = 0.f;
#pragma unroll
    for (int j = 0; j < 4; ++j) { v[j] = ((const float4*)xr)[lane + 64 * j]; s += v[j].x * v[j].x + v[j].y * v[j].y + v[j].z * v[j].z + v[j].w * v[j].w; }
    s = wave_sum(s);
    const float rs = 1.0f / sqrtf(s * (1.0f / 1024.0f) + 1e-6f);
#pragma unroll
    for (int j = 0; j < 4; ++j) { const float4 gg = ((const float4*)g)[lane + 64 * j];
        v[j].x *= rs * gg.x; v[j].y *= rs * gg.y; v[j].z *= rs * gg.z; v[j].w *= rs * gg.w;
        ((uint2*)o)[lane + 64 * j] = make_uint2(pk2(v[j].x, v[j].y), pk2(v[j].z, v[j].w)); }
}
__device__ __forceinline__ void rms_row(const float* xr, const float* g, float* o, int lane, float4 (&v)[4]) {
    float s = 0.f;
#pragma unroll
    for (int j = 0; j < 4; ++j) { v[j] = ((const float4*)xr)[lane + 64 * j]; s += v[j].x * v[j].x + v[j].y * v[j].y + v[j].z * v[j].z + v[j].w * v[j].w; }
    s = wave_sum(s);
    const float rs = 1.0f / sqrtf(s * (1.0f / 1024.0f) + 1e-6f);
#pragma unroll
    for (int j = 0; j < 4; ++j) { const float4 gg = ((const float4*)g)[lane + 64 * j];
        v[j].x *= rs * gg.x; v[j].y *= rs * gg.y; v[j].z *= rs * gg.z; v[j].w *= rs * gg.w; ((float4*)o)[lane + 64 * j] = v[j]; }
}
typedef short bf16x8 __attribute__((ext_vector_type(8)));
typedef short s16x4 __attribute__((ext_vector_type(4)));
typedef float f32x4 __attribute__((ext_vector_type(4)));
typedef LAS s16x4 lds_s16x4;
typedef unsigned u32x4_t __attribute__((ext_vector_type(4)));
typedef unsigned u32x2_w __attribute__((ext_vector_type(2)));
#define MFMA16(a, b, c) __builtin_amdgcn_mfma_f32_16x16x32_bf16((a), (b), (c), 0, 0, 0)
__device__ __forceinline__ bf16x8 tr_frag(const LAS unsigned char* p0, const LAS unsigned char* p1) {
    const s16x4 a = __builtin_amdgcn_ds_read_tr16_b64_v4i16((lds_s16x4*)p0), b = __builtin_amdgcn_ds_read_tr16_b64_v4i16((lds_s16x4*)p1);
    return __builtin_shufflevector(a, b, 0, 1, 2, 3, 4, 5, 6, 7);
}
__device__ __forceinline__ bf16x8 pack8(const f32x4 a, const f32x4 b) {
    uint4 u; u.x = pkbf(a[0], a[1]); u.y = pkbf(a[2], a[3]); u.z = pkbf(b[0], b[1]); u.w = pkbf(b[2], b[3]); return __builtin_bit_cast(bf16x8, u);
}

constexpr int MA_PITCH = 272, MA_VOFF = 256 * MA_PITCH;
__device__ __forceinline__ void mem_attn_phase(LAS unsigned char* L, const bf16* projb, const bf16* kmem, const bf16* vmem, bf16* ycr, float* pss, int bid, int G) {
    int tid = threadIdx.x; asm volatile("" : "+v"(tid));
    const int lane = tid & 63, wave = __builtin_amdgcn_readfirstlane(tid >> 6), fr = lane & 15, g = lane >> 4, q = fr >> 2, pp = lane & 3;
    for (int u = bid; u < 256; u += G) {
        const int bh = u >> 4, chunk = u & 15, b = bh >> 2, hm = bh & 3;
        __syncthreads();
        {
            const u32x4_t* ksrc = (const u32x4_t*)(kmem + (size_t)bh * 256 * 128); const u32x4_t* vsrc = (const u32x4_t*)(vmem + (size_t)bh * 256 * 128);
            u32x4_t kr[8], vr[8];
#pragma unroll
            for (int i = 0; i < 8; ++i) { kr[i] = ksrc[tid + 512 * i]; vr[i] = vsrc[tid + 512 * i]; }
#pragma unroll
            for (int i = 0; i < 8; ++i) { const int pc = tid + 512 * i, row = pc >> 4, ch = pc & 15;
                *(LAS u32x4_t*)(L + row * MA_PITCH + ch * 16) = kr[i]; *(LAS u32x4_t*)(L + MA_VOFF + row * MA_PITCH + ch * 16) = vr[i]; }
        }
        __syncthreads();
        bf16x8 qn[4];
        { const int tok0 = (b << 13) + chunk * 512 + wave * 16 + fr;
#pragma unroll
          for (int kc = 0; kc < 4; ++kc) qn[kc] = __builtin_nontemporal_load((const bf16x8*)(projb + (size_t)tok0 * PW + 2048 + hm * 128 + 32 * kc + 8 * g)); }
        for (int ti = wave; ti < 32; ti += 8) {
            const int tok = (b << 13) + chunk * 512 + ti * 16 + fr;
            bf16x8 qf[4];
#pragma unroll
            for (int kc = 0; kc < 4; ++kc) qf[kc] = qn[kc];
            { const int tokn = (b << 13) + chunk * 512 + (ti + 8 < 32 ? ti + 8 : ti) * 16 + fr;
#pragma unroll
              for (int kc = 0; kc < 4; ++kc) qn[kc] = __builtin_nontemporal_load((const bf16x8*)(projb + (size_t)tokn * PW + 2048 + hm * 128 + 32 * kc + 8 * g)); }
            f32x4 s[16];
#pragma unroll
            for (int kb = 0; kb < 16; ++kb) { s[kb] = (f32x4){0.f, 0.f, 0.f, 0.f};
#pragma unroll
                for (int kc = 0; kc < 4; ++kc) { const bf16x8 kf = *(const LAS bf16x8*)(L + (16 * kb + fr) * MA_PITCH + (32 * kc + 8 * g) * 2); s[kb] = MFMA16(kf, qf[kc], s[kb]); }
                if (kb & 1) __builtin_amdgcn_sched_barrier(0); }
            const float sc = 0.08838834764831845f * 1.4426950408889634f;
            float mx = -3.0e38f;
#pragma unroll
            for (int kb = 0; kb < 16; ++kb) { s[kb] = s[kb] * sc; mx = fmaxf(mx, fmaxf(fmaxf(s[kb][0], s[kb][1]), fmaxf(s[kb][2], s[kb][3]))); }
            mx = fmaxf(mx, __shfl_xor(mx, 16)); mx = fmaxf(mx, __shfl_xor(mx, 32));
            float sum = 0.f;
#pragma unroll
            for (int kb = 0; kb < 16; ++kb) {
#pragma unroll
                for (int i = 0; i < 4; ++i) { const float e = __builtin_amdgcn_exp2f(s[kb][i] - mx); s[kb][i] = e; sum += e; } }
            sum += __shfl_xor(sum, 16); sum += __shfl_xor(sum, 32);
            f32x4 o[8];
#pragma unroll
            for (int db = 0; db < 8; ++db) o[db] = (f32x4){0.f, 0.f, 0.f, 0.f};
#pragma unroll
            for (int c = 0; c < 8; ++c) {
                const bf16x8 pf = pack8(s[2 * c], s[2 * c + 1]);
                const LAS unsigned char* vb = L + MA_VOFF + (32 * c + 4 * g + q) * MA_PITCH + 8 * pp;
#pragma unroll
                for (int db = 0; db < 8; ++db) { const bf16x8 vf = tr_frag(vb + 32 * db, vb + 16 * MA_PITCH + 32 * db); o[db] = MFMA16(vf, pf, o[db]); }
                __builtin_amdgcn_sched_barrier(0);
            }
            const float inv = 1.0f / sum;
            bf16* orow0 = ycr + (size_t)tok * MIXW + 1024 + hm * 128;
            float ss = 0.f;
#pragma unroll
            for (int dp = 0; dp < 4; ++dp) { unsigned x0[2], x1[2];
#pragma unroll
                for (int t = 0; t < 2; ++t) { const f32x4 v = o[2 * dp + t] * inv; ss += (v[0] * v[0] + v[1] * v[1]) + (v[2] * v[2] + v[3] * v[3]); x0[t] = pkbf(v[0], v[1]); x1[t] = pkbf(v[2], v[3]); }
                const u32x2_w s0 = __builtin_amdgcn_permlane16_swap(x0[0], x0[1], false, false), s1 = __builtin_amdgcn_permlane16_swap(x1[0], x1[1], false, false);
                *(u32x4_t*)(orow0 + 16 * (2 * dp + (g & 1)) + 8 * (g >> 1)) = (u32x4_t){s0[0], s1[0], s0[1], s1[1]}; }
            ss += __shfl_xor(ss, 16); ss += __shfl_xor(ss, 32);
            if (g == 0) pss[(size_t)tok * 12 + 8 + hm] = ss;
        }
    }
    __syncthreads();
}

constexpr int NA_PITCH = 144, NA_VOFF = 512 * NA_PITCH, NA_BOFF = 2 * 512 * NA_PITCH;
__device__ __forceinline__ void na_attn_phase(LAS unsigned char* L, const bf16* projb, const float* rel_bias, bf16* ycr, float* pss, int bid, int G) {
    int tid = threadIdx.x; asm volatile("" : "+v"(tid));
    const int lane = tid & 63, wave = __builtin_amdgcn_readfirstlane(tid >> 6), fr = lane & 15, g = lane >> 4, q = fr >> 2, pp = lane & 3;
    LAS float* bias_s = (LAS float*)(L + NA_BOFF);
    for (int sq = bid; sq < 256; sq += G) {
        const int qb = sq & 3, h = (sq >> 2) & 7, half = (sq >> 5) & 1, b = sq >> 6;
        const int c0 = qb == 0 ? 0 : qb == 1 ? 8 : qb == 2 ? 24 : 32;
        __syncthreads();
        bf16x8 qn[2];
        {
            const int r0 = 64 * half, wr0 = min(max(r0 - 4, 0), 120), wr1 = min(r0 + 3, 120) + 7, nrows = wr1 - wr0 + 1;
#pragma unroll
            for (int kc = 0; kc < 2; ++kc) qn[kc] = __builtin_nontemporal_load((const bf16x8*)(projb + (size_t)((b << 13) + (64 * half + wave) * 64 + 16 * qb + fr) * PW + h * 64 + 32 * kc + 8 * g));
            u32x4_t rg[15];
#pragma unroll
            for (int i = 0; i < 15; ++i) {
                if (i < nrows) { const int cc = tid >> 4, part = tid & 15, isv = part >> 3, ch = part & 7;
                    const int tok = (b << 13) + (wr0 + i) * 64 + c0 + cc;
                    rg[i] = *(const u32x4_t*)(projb + (size_t)tok * PW + (isv ? 1024 : 512) + h * 64 + ch * 8); } }
#pragma unroll
            for (int i = 0; i < 15; ++i) {
                if (i < nrows) { const int cc = tid >> 4, part = tid & 15, isv = part >> 3, ch = part & 7;
                    *(LAS u32x4_t*)(L + (isv ? NA_VOFF : 0) + (((wr0 + i) & 15) * 32 + cc) * NA_PITCH + ch * 16) = rg[i]; } }
            if (tid < 465) bias_s[16 + tid] = rel_bias[h * 465 + tid] * 1.4426950408889634f;
        }
        for (int i8 = 0; i8 < 8; ++i8) {
            const int ro = 8 * half + i8, r0 = 8 * ro, wr1 = min(r0 + 3, 120) + 7;
            const int nnew = i8 < 7 ? (min(r0 + 11, 120) + 7) - wr1 : 0;
            __syncthreads();
            const int r = r0 + wave, rs = min(max(r - 4, 0), 120);
            const int cq = 16 * qb + fr, cs = min(max(cq - 8, 0), 48);
            const int tok = (b << 13) + r * 64 + cq;
            bf16x8 qf[2];
            qf[0] = qn[0]; qf[1] = qn[1];
            asm volatile("" ::: "memory");
            u32x4_t rn[8];
#pragma unroll
            for (int i = 0; i < 8; ++i) { const int lr = i < nnew ? i : (nnew > 0 ? nnew - 1 : 0), key = tid >> 4, part = tid & 15, isv = part >> 3, ch = part & 7;
                const int tokn = (b << 13) + min(wr1 + 1 + lr, 127) * 64 + c0 + key;
                rn[i] = *(const u32x4_t*)(projb + (size_t)tokn * PW + (isv ? 1024 : 512) + h * 64 + ch * 8); }
            f32x4 s[16];
            float bv[8][4], bw[8][4];
            const LAS float* bp0 = bias_s + 16 + (rs - r + 7) * 31 + 15 + (c0 + 4 * g - cq);
#pragma unroll
            for (int kq = 0; kq < 4; ++kq) {
                bf16x8 kf[4][2];
#pragma unroll
                for (int kk = 0; kk < 4; ++kk) { const int kb = 4 * kq + kk;
                    const LAS unsigned char* kp = L + ((((rs + (kb >> 1)) & 15)) * 32 + 16 * (kb & 1) + fr) * NA_PITCH + 16 * g;
                    kf[kk][0] = *(const LAS bf16x8*)kp; kf[kk][1] = *(const LAS bf16x8*)(kp + 64); }
                if (kq == 0) {
#pragma unroll
                    for (int kb = 0; kb < 8; ++kb)
#pragma unroll
                        for (int i = 0; i < 4; ++i) bv[kb][i] = bp0[16 * (kb & 1) + 31 * (kb >> 1) + i]; }
                __builtin_amdgcn_sched_barrier(0);
#pragma unroll
                for (int kk = 0; kk < 4; ++kk) { const int kb = 4 * kq + kk; s[kb] = MFMA16(kf[kk][0], qf[0], ((f32x4){0.f, 0.f, 0.f, 0.f})); s[kb] = MFMA16(kf[kk][1], qf[1], s[kb]); }
                __builtin_amdgcn_sched_barrier(0);
            }
            bool okc[2][4];
#pragma unroll
            for (int hf = 0; hf < 2; ++hf)
#pragma unroll
                for (int i = 0; i < 4; ++i) { const int ck = c0 + 16 * hf + 4 * g + i; okc[hf][i] = (ck >= cs) && (ck < cs + 16); }
#pragma unroll
            for (int kb = 8; kb < 16; ++kb)
#pragma unroll
                for (int i = 0; i < 4; ++i) bw[kb - 8][i] = bp0[16 * (kb & 1) + 31 * (kb >> 1) + i];
            __builtin_amdgcn_sched_barrier(0);
            float mx = -3.0e38f;
#pragma unroll
            for (int kb = 0; kb < 16; ++kb) {
                const int hf = kb & 1;
#pragma unroll
                for (int i = 0; i < 4; ++i) { const float v = okc[hf][i] ? fmaf(s[kb][i], 0.125f * 1.4426950408889634f, kb < 8 ? bv[kb][i] : bw[kb - 8][i]) : -3.0e38f; s[kb][i] = v; mx = fmaxf(mx, v); } }
            mx = fmaxf(mx, __shfl_xor(mx, 16)); mx = fmaxf(mx, __shfl_xor(mx, 32));
            float sum = 0.f;
#pragma unroll
            for (int kb = 0; kb < 16; ++kb) {
#pragma unroll
                for (int i = 0; i < 4; ++i) { const float e = __builtin_amdgcn_exp2f(s[kb][i] - mx); s[kb][i] = e; sum += e; } }
            sum += __shfl_xor(sum, 16); sum += __shfl_xor(sum, 32);
            { const int tokq = (b << 13) + (min(r0 + 8, 64 * half + 56) + wave) * 64 + cq;
#pragma unroll
              for (int kc = 0; kc < 2; ++kc) qn[kc] = __builtin_nontemporal_load((const bf16x8*)(projb + (size_t)tokq * PW + h * 64 + 32 * kc + 8 * g)); }
            f32x4 o[4];
#pragma unroll
            for (int db = 0; db < 4; ++db) o[db] = (f32x4){0.f, 0.f, 0.f, 0.f};
#pragma unroll
            for (int jp = 0; jp < 4; ++jp) {
                bf16x8 vf[2][4];
#pragma unroll
                for (int jj = 0; jj < 2; ++jj) { const int j = 2 * jp + jj;
                    const LAS unsigned char* vb = L + NA_VOFF + (((rs + j) & 15) * 32 + 4 * g + q) * NA_PITCH + 8 * pp;
#pragma unroll
                    for (int db = 0; db < 4; ++db) vf[jj][db] = tr_frag(vb + 32 * db, vb + 16 * NA_PITCH + 32 * db); }
                __builtin_amdgcn_sched_barrier(0);
#pragma unroll
                for (int jj = 0; jj < 2; ++jj) { const int j = 2 * jp + jj; const bf16x8 pf = pack8(s[2 * j], s[2 * j + 1]);
#pragma unroll
                    for (int db = 0; db < 4; ++db) o[db] = MFMA16(vf[jj][db], pf, o[db]); }
                __builtin_amdgcn_sched_barrier(0);
            }
            const float inv = 1.0f / sum;
            bf16* orow0 = ycr + (size_t)tok * MIXW + h * 64;
            float ss = 0.f;
#pragma unroll
            for (int dp = 0; dp < 2; ++dp) { unsigned x0[2], x1[2];
#pragma unroll
                for (int t = 0; t < 2; ++t) { const f32x4 v = o[2 * dp + t] * inv; ss += (v[0] * v[0] + v[1] * v[1]) + (v[2] * v[2] + v[3] * v[3]); x0[t] = pkbf(v[0], v[1]); x1[t] = pkbf(v[2], v[3]); }
                const u32x2_w s0 = __builtin_amdgcn_permlane16_swap(x0[0], x0[1], false, false), s1 = __builtin_amdgcn_permlane16_swap(x1[0], x1[1], false, false);
                *(u32x4_t*)(orow0 + 16 * (2 * dp + (g & 1)) + 8 * (g >> 1)) = (u32x4_t){s0[0], s1[0], s0[1], s1[1]}; }
            ss += __shfl_xor(ss, 16); ss += __shfl_xor(ss, 32);
            if (g == 0) pss[(size_t)tok * 12 + h] = ss;
            __syncthreads();
#pragma unroll
            for (int i = 0; i < 8; ++i)
                if (i < nnew) { const int key = tid >> 4, part = tid & 15, isv = part >> 3, ch = part & 7;
                    *(LAS u32x4_t*)(L + (isv ? NA_VOFF : 0) + (((wr1 + 1 + i) & 15) * 32 + key) * NA_PITCH + ch * 16) = rn[i]; }
        }
    }
    __syncthreads();
}
typedef unsigned u32x2_t __attribute__((ext_vector_type(2)));
constexpr int FT_PITCH = 528, FT_OS1 = 128 * FT_PITCH;
constexpr int FT_UP = 272;
__device__ __forceinline__ void ft_stage1_phase(LAS unsigned char* L, const bf16* projb, bf16* Mid, const bf16* tabC, const bf16* tabS, const bf16* tabSn, const float2* tab8192, int bid, int G) {
    int tid = threadIdx.x; asm volatile("" : "+v"(tid));
    const int lane = tid & 63, wave = __builtin_amdgcn_readfirstlane(tid >> 6), fr = lane & 15, g4 = lane >> 4, q = fr >> 2, pp = lane & 3;
    bf16x8 fC[4], fS[4], fSn[4], fD[2][4];
#pragma unroll
    for (int kc = 0; kc < 4; ++kc) { const size_t o = (size_t)(16 * wave + fr) * 128 + 32 * kc + 8 * g4; fC[kc] = *(const bf16x8*)(tabC + o); fS[kc] = *(const bf16x8*)(tabS + o); fSn[kc] = *(const bf16x8*)(tabSn + o);
#pragma unroll
        for (int t = 0; t < 2; ++t) { const int nb = 2 * wave + t; const bf16* tb = nb < 8 ? tabC : tabSn; fD[t][kc] = *(const bf16x8*)(tb + (size_t)(16 * (nb & 7) + fr) * 128 + 32 * kc + 8 * g4); } }
#define FT1_LOAD(uu) do { const int _g = (uu) & 3, _c = ((uu) >> 2) & 63, _b = (uu) >> 8; _Pragma("unroll") for (int i = 0; i < 4; ++i) { const int r = (tid >> 4) + 32 * i, ch = tid & 15; \
        rg[i] = __builtin_nontemporal_load((const u32x4_t*)(projb + (size_t)((_b << 13) + 64 * r + _c) * PW + 1536 + _g * 128 + ch * 8)); } } while (0)
    u32x4_t rg[4];
    if (bid < 1024) FT1_LOAD(bid);
    for (int u = bid; u < 1024; u += G) {
        const int g = u & 3, c = (u >> 2) & 63, b = u >> 8;
#pragma unroll
        for (int i = 0; i < 4; ++i) { const int r = (tid >> 4) + 32 * i, ch = tid & 15; *(LAS u32x4_t*)(L + FT_OS1 + r * FT_UP + ch * 16) = rg[i]; }
        __syncthreads();
        { const int un = u + G < 1024 ? u + G : u; FT1_LOAD(un); }
        {
#pragma unroll
            for (int mp = 0; mp < 4; ++mp) {
                bf16x8 bu[2][4];
#pragma unroll
                for (int mm = 0; mm < 2; ++mm)
#pragma unroll
                    for (int kc = 0; kc < 4; ++kc) bu[mm][kc] = *(const LAS bf16x8*)(L + FT_OS1 + (16 * (2 * mp + mm) + fr) * FT_UP + (32 * kc + 8 * g4) * 2);
                __builtin_amdgcn_sched_barrier(0);
#pragma unroll
                for (int mm = 0; mm < 2; ++mm) { const int mb = 2 * mp + mm;
                    f32x4 v0 = {0.f, 0.f, 0.f, 0.f}, v1 = {0.f, 0.f, 0.f, 0.f};
#pragma unroll
                    for (int kc = 0; kc < 4; ++kc) { v0 = MFMA16(fD[0][kc], bu[mm][kc], v0); v1 = MFMA16(fD[1][kc], bu[mm][kc], v1); }
                    LAS unsigned char* xr = L + (16 * mb + fr) * FT_PITCH + (32 * wave + 4 * g4) * 2;
                    *(LAS u32x2_t*)(xr) = (u32x2_t){pkbf(v0[0], v0[1]), pkbf(v0[2], v0[3])};
                    *(LAS u32x2_t*)(xr + 32) = (u32x2_t){pkbf(v1[0], v1[1]), pkbf(v1[2], v1[3])}; }
                __builtin_amdgcn_sched_barrier(0);
            }
        }
        __syncthreads();
        {
            const int k1 = 16 * wave + fr;
            const float2 tw = tab8192[k1 * c];
            LAS unsigned char* orow = L + FT_OS1 + k1 * FT_PITCH + 8 * g4;
#pragma unroll
            for (int nb = 0; nb < 8; ++nb) {
                f32x4 re = {0.f, 0.f, 0.f, 0.f}, im = {0.f, 0.f, 0.f, 0.f};
                bf16x8 ar[4], ai[4];
#pragma unroll
                for (int kc = 0; kc < 4; ++kc) {
                    const LAS unsigned char* xp = L + (32 * kc + 8 * g4 + q) * FT_PITCH + 32 * nb + 8 * pp;
                    ar[kc] = tr_frag(xp, xp + 4 * FT_PITCH); ai[kc] = tr_frag(xp + 256, xp + 256 + 4 * FT_PITCH); }
                __builtin_amdgcn_sched_barrier(0);
#pragma unroll
                for (int kc = 0; kc < 4; ++kc) { re = MFMA16(ar[kc], fC[kc], re); re = MFMA16(ai[kc], fS[kc], re); im = MFMA16(ai[kc], fC[kc], im); im = MFMA16(ar[kc], fSn[kc], im); }
                const f32x4 ore = re * tw.x + im * tw.y, oim = im * tw.x - re * tw.y;
                *(LAS u32x2_t*)(orow + 32 * nb) = (u32x2_t){pkbf(ore[0], ore[1]), pkbf(ore[2], ore[3])};
                *(LAS u32x2_t*)(orow + 256 + 32 * nb) = (u32x2_t){pkbf(oim[0], oim[1]), pkbf(oim[2], oim[3])};
                __builtin_amdgcn_sched_barrier(0);
            }
        }
        __syncthreads();
        {
#pragma unroll
            for (int i = 0; i < 8; ++i) { const int pc = tid + 512 * i, k1 = pc >> 5, ch = pc & 31;
                *(u32x4_t*)(Mid + ((size_t)(((b * 128 + k1) * 4 + g) * 64 + c)) * 256 + ch * 8) = *(const LAS u32x4_t*)(L + FT_OS1 + k1 * FT_PITCH + ch * 16); }
        }
        __syncthreads();
    }
    __syncthreads();
#undef FT1_LOAD
}
constexpr int FT_XS2 = 64 * FT_PITCH, FT_OS2 = 2 * FT_XS2, FT_OP2 = 1040;
__device__ __forceinline__ void ft_stage2_phase(LAS unsigned char* L, const bf16* Mid, bf16* yout, const bf16* tab2, float* pss2, int bid, int G) {
    int tid = threadIdx.x; asm volatile("" : "+v"(tid));
    const int lane = tid & 63, wave = __builtin_amdgcn_readfirstlane(tid >> 6), fr = lane & 15, g4 = lane >> 4, q = fr >> 2, pp = lane & 3;
    bf16x8 fT[4][4];
#pragma unroll
    for (int kb = 0; kb < 4; ++kb)
#pragma unroll
        for (int kc = 0; kc < 4; ++kc) fT[kb][kc] = *(const bf16x8*)(tab2 + (size_t)(16 * kb + fr) * 128 + 32 * kc + 8 * g4);
    for (int u = bid; u < 512; u += G) {
        const int k1 = u & 127, b = u >> 7;
        const bf16* src = Mid + (size_t)((b * 128 + k1) * 4) * 64 * 256;
        u32x4_t rg[4];
#pragma unroll
        for (int i = 0; i < 4; ++i) rg[i] = __builtin_nontemporal_load((const u32x4_t*)(src + (size_t)(tid + 512 * i) * 8));
#pragma unroll
        for (int i = 0; i < 4; ++i) { const int pc = tid + 512 * i, c = pc >> 5, ch = pc & 31; *(LAS u32x4_t*)(L + c * FT_PITCH + ch * 16) = rg[i]; }
        __syncthreads();
#pragma unroll
        for (int g = 0; g < 4; ++g) {
            if (g < 3) {
#pragma unroll
                for (int i = 0; i < 4; ++i) rg[i] = __builtin_nontemporal_load((const u32x4_t*)(src + (size_t)(g + 1) * 64 * 256 + (size_t)(tid + 512 * i) * 8));
            }
            const LAS unsigned char* X = L + (g & 1) * FT_XS2;
            f32x4 acc[4];
#pragma unroll
            for (int kb = 0; kb < 4; ++kb) acc[kb] = (f32x4){0.f, 0.f, 0.f, 0.f};
#pragma unroll
            for (int kc = 0; kc < 4; ++kc) {
                const LAS unsigned char* xp = X + (32 * (kc & 1) + 8 * g4 + q) * FT_PITCH + (kc >> 1) * 256 + 32 * wave + 8 * pp;
                const bf16x8 a = tr_frag(xp, xp + 4 * FT_PITCH);
#pragma unroll
                for (int kb = 0; kb < 4; ++kb) acc[kb] = MFMA16(a, fT[kb][kc], acc[kb]);
            }
#pragma unroll
            for (int kb = 0; kb < 4; ++kb) { const f32x4 v = acc[kb] * (1.0f / 1024.0f);
                *(LAS u32x2_t*)(L + FT_OS2 + (16 * kb + fr) * FT_OP2 + (g * 128 + 16 * wave + 4 * g4) * 2) = (u32x2_t){pkbf(v[0], v[1]), pkbf(v[2], v[3])}; }
            if (g < 3) {
#pragma unroll
                for (int i = 0; i < 4; ++i) { const int pc = tid + 512 * i, c = pc >> 5, ch = pc & 31; *(LAS u32x4_t*)(L + ((g + 1) & 1) * FT_XS2 + c * FT_PITCH + ch * 16) = rg[i]; }
            }
            __syncthreads();
        }
#pragma unroll
        for (int j = 0; j < 8; ++j) {
            const int k2 = 8 * wave + j;
            const u32x4_t raw = *(const LAS u32x4_t*)(L + FT_OS2 + k2 * FT_OP2 + lane * 16);
            float f0 = __builtin_bit_cast(float, raw.x << 16), f1 = __builtin_bit_cast(float, raw.x & 0xffff0000u), f2 = __builtin_bit_cast(float, raw.y << 16), f3 = __builtin_bit_cast(float, raw.y & 0xffff0000u);
            float f4 = __builtin_bit_cast(float, raw.z << 16), f5 = __builtin_bit_cast(float, raw.z & 0xffff0000u), f6 = __builtin_bit_cast(float, raw.w << 16), f7 = __builtin_bit_cast(float, raw.w & 0xffff0000u);
            float s = (f0 * f0 + f1 * f1) + (f2 * f2 + f3 * f3) + (f4 * f4 + f5 * f5) + (f6 * f6 + f7 * f7);
            s = wave_sum(s);
            const size_t tok = (size_t)((b << 13) + k1 + 128 * k2);
            *(u32x4_t*)(yout + tok * MIXW + 512 + lane * 8) = raw;
            if (lane == 0) pss2[tok] = s;
        }
    }
    __syncthreads();
}

template <class AF, class BF>
__device__ __forceinline__ void naive_tile(float* sm, int K, AF af, BF bf, float (&acc)[8][4]) {
    float (*As)[132] = (float (*)[132])sm; float (*Bs)[132] = (float (*)[132])(sm + 16 * 132);
    const int tid = threadIdx.x, tx = tid & 31, ty = tid >> 5;
#pragma unroll
    for (int i = 0; i < 8; ++i)
#pragma unroll
        for (int j = 0; j < 4; ++j) acc[i][j] = 0.f;
    for (int k0 = 0; k0 < K; k0 += 16) {
        { const int r = tid >> 2, kk = (tid & 3) * 4;
#pragma unroll
          for (int j = 0; j < 4; ++j) As[kk + j][r] = af(r, k0 + kk + j); }
        { const int kk = tid >> 5, c = (tid & 31) * 4;
#pragma unroll
          for (int j = 0; j < 4; ++j) Bs[kk][c + j] = bf(k0 + kk, c + j); }
        __syncthreads();
#pragma unroll
        for (int kk = 0; kk < 16; ++kk) {
            float a[8], b[4];
#pragma unroll
            for (int i = 0; i < 8; ++i) a[i] = As[kk][ty * 8 + i];
#pragma unroll
            for (int j = 0; j < 4; ++j) b[j] = Bs[kk][(j >> 1) * 64 + tx * 2 + (j & 1)];
#pragma unroll
            for (int i = 0; i < 8; ++i)
#pragma unroll
                for (int j = 0; j < 4; ++j) acc[i][j] += a[i] * b[j];
        }
        __syncthreads();
    }
}

#define PHASE_IDS int tid_ = threadIdx.x; asm volatile("" : "+v"(tid_)); const int tid = tid_, lane = tid & 63, wave = __builtin_amdgcn_readfirstlane(tid >> 6); (void)lane; (void)wave;
__global__ void __launch_bounds__(NTH, 2) mk_fwd(Params p) {
    extern __shared__ __attribute__((aligned(16))) unsigned char lds[];
    const int tid = threadIdx.x, lane = tid & 63, wave = __builtin_amdgcn_readfirstlane(tid >> 6);
    const int G = gridDim.x, bid = blockIdx.x;
    unsigned char* ws = p.ws;
    unsigned* ctl = (unsigned*)(ws + WS_CTL);
    LAS unsigned char* L = (LAS unsigned char*)lds;
    volatile LAS unsigned* xbw = (volatile LAS unsigned*)(L + LDS_XBW);
    if (tid < 4) xbw[tid] = 0u;
    __syncthreads();
    XcdBarrier bar = xcd_barrier_post(ctl + CW_BAR, xbw);
    float* sm = (float*)lds;
    LAS int* sbase = (LAS int*)(L + LDS_SBASE); LAS int* scnt = (LAS int*)(L + LDS_SBASE + 256); LAS int* tile_e = (LAS int*)(L + LDS_TILEE); LAS int* idxbuf = (LAS int*)(L + LDS_IDX);

    float2* tab128 = (float2*)(ws + WS_TAB128); float2* tab64 = (float2*)(ws + WS_TAB64); float2* tab8192 = (float2*)(ws + WS_TAB8192);
    bf16* memn = (bf16*)(ws + WS_MEMN); bf16* WkvT = (bf16*)(ws + WS_WKV); bf16* kmem = (bf16*)(ws + WS_KMEM); bf16* vmem = (bf16*)(ws + WS_VMEM);
    unsigned* bbase = (unsigned*)(ws + WS_BBASE);
    int* ident = (int*)(ws + WS_IDENT); float* pss = (float*)(ws + WS_PSS); float* pss2 = (float*)(ws + WS_PSS2);
    float* rsbuf = (float*)(ws + WS_RSBUF); float* slot_rs = (float*)(ws + WS_SLOTRS); bf16* RwH = (bf16*)(ws + WS_RWH); bf16* RwL = (bf16*)(ws + WS_RWL);
    int* tok_e = (int*)(ws + WS_TOKE); float* tok_g = (float*)(ws + WS_TOKG); int* tok_pos = (int*)(ws + WS_TOKPOS); int* tok_slot = (int*)(ws + WS_TOKSLOT);
    int* slot_tok = (int*)(ws + WS_SLOTTOK); float* slot_gate = (float*)(ws + WS_SLOTGATE);
    bf16* WinT = (bf16*)(ws + WS_WIN); bf16* WoutT = (bf16*)(ws + WS_WOUT); unsigned char* WguT = ws + WS_WGU; unsigned char* WdT = ws + WS_WD; unsigned char* h8 = ws + WS_H8; unsigned char* act = ws + WS_PROJ;
    bf16* hb = (bf16*)(ws + WS_HB); bf16* projb = (bf16*)(ws + WS_PROJ); bf16* Mid = (bf16*)(ws + WS_MID);
    bf16* tabC = (bf16*)(ws + WS_TABC); bf16* tabS = (bf16*)(ws + WS_TABS); bf16* tabSn = (bf16*)(ws + WS_TABSN); bf16* tab2 = (bf16*)(ws + WS_TAB2);
    bf16* ycr = (bf16*)(ws + WS_YCAT); unsigned char* Yb = ws + WS_Y; bf16* ycatn = (bf16*)(ws + WS_YCATN); bf16* Vbuf = (bf16*)(ws + WS_V);
    bf16* x1b = hb;

    {
        PHASE_IDS
        float4 va[4], vb[4];
        { const int m0_ = 2 * (bid * 8 + wave);
#pragma unroll
          for (int j = 0; j < 4; ++j) { va[j] = ld_nt_f4(p.x + (size_t)m0_ * D + 4 * (lane + 64 * j)); vb[j] = ld_nt_f4(p.x + (size_t)(m0_ + 1) * D + 4 * (lane + 64 * j)); } }
        for (int i = bid * NTH + tid; i < 8192; i += G * NTH) {
            tab8192[i] = make_float2(cospif(2.0f * (float)i / 8192.0f), sinpif(2.0f * (float)i / 8192.0f));
            if (i < 128) tab128[i] = make_float2(cospif(2.0f * (float)i / 128.0f), sinpif(2.0f * (float)i / 128.0f));
            if (i < 64) tab64[i] = make_float2(cospif(2.0f * (float)i / 64.0f), sinpif(2.0f * (float)i / 64.0f));
        }
        for (int i = bid * NTH + tid; i < 32 * 1024; i += G * NTH) {
            const int e = i >> 10, k = i & 1023; const float w = p.router_w[(size_t)k * 32 + e]; const unsigned hi = f2bf(w);
            RwH[i] = (bf16)hi; RwL[i] = (bf16)f2bf(w - bf2f((bf16)hi));
        }
        for (int i = bid * NTH + tid; i < 128 * 128; i += G * NTH) {
            const int k1 = i >> 7, r = i & 127, ph = (k1 * r) & 127; const float cs = cospif(2.0f * (float)ph / 128.0f), sn = sinpif(2.0f * (float)ph / 128.0f);
            tabC[i] = (bf16)f2bf(cs); tabS[i] = (bf16)f2bf(sn); tabSn[i] = (bf16)f2bf(-sn);
            if (i < 64 * 128) { const int k2 = i >> 7, kk = i & 127, c = kk & 63, p2 = (k2 * c) & 63; tab2[i] = (bf16)f2bf(kk < 64 ? cospif(2.0f * (float)p2 / 64.0f) : sinpif(2.0f * (float)p2 / 64.0f)); }
        }
        LAS float* scr = (LAS float*)(L + wave * 17408);
        const int gw = bid * 8 + wave, NGW = G * 8;
        constexpr int I_IN = 16 * 80, I_OUT = 24 * 32, I_KV = 16 * 32;
        for (int it = gw; it < I_KV + I_IN + I_OUT; it += NGW) {
            int r = it;
            if (r < I_KV) { const int kb = r / 32, nb = r % 32; transpose_item(p.w_mem_kv, 1024, 1024, WkvT, nb * 32, kb * 64, nb * 32, scr, lane); continue; } r -= I_KV;
            if (r < I_IN) { const int kb = r / 80, nb = r % 80; transpose_item(p.w_in, INW, 1024, WinT, nb * 32, kb * 64, nb * 32, scr, lane); continue; } r -= I_IN;
            { const int kb = r / 32, nb = r % 32; transpose_item(p.w_out, 1024, MIXW, WoutT, nb * 32, kb * 64, nb * 32, scr, lane, p.g_grp); }
        }
        {
            float4 gmx[4];
#pragma unroll
            for (int j = 0; j < 4; ++j) gmx[j] = ((const float4*)p.g_mix)[lane + 64 * j];
#define P0_LOAD(m_, va_, vb_) do { const int _m = (m_) < T ? (m_) : T - 2; _Pragma("unroll") for (int j = 0; j < 4; ++j) { va_[j] = ld_nt_f4(p.x + (size_t)_m * D + 4 * (lane + 64 * j)); vb_[j] = ld_nt_f4(p.x + (size_t)(_m + 1) * D + 4 * (lane + 64 * j)); } } while (0)
#define P0_ROWS(m_, va_, vb_) do { if ((m_) < T) { float sa = 0.f, sb = 0.f; \
            _Pragma("unroll") for (int j = 0; j < 4; ++j) { sa += va_[j].x * va_[j].x + va_[j].y * va_[j].y + va_[j].z * va_[j].z + va_[j].w * va_[j].w; sb += vb_[j].x * vb_[j].x + vb_[j].y * vb_[j].y + vb_[j].z * vb_[j].z + vb_[j].w * vb_[j].w; } \
            sa = wave_sum(sa); sb = wave_sum(sb); \
            const float ra = 1.0f / sqrtf(sa * (1.0f / 1024.0f) + 1e-6f), rb = 1.0f / sqrtf(sb * (1.0f / 1024.0f) + 1e-6f); \
            _Pragma("unroll") for (int j = 0; j < 4; ++j) { const float4 gg = gmx[j]; \
                ((uint2*)(hb + (size_t)(m_) * D))[lane + 64 * j] = make_uint2(pkbf(va_[j].x * ra * gg.x, va_[j].y * ra * gg.y), pkbf(va_[j].z * ra * gg.z, va_[j].w * ra * gg.w)); \
                ((uint2*)(hb + (size_t)((m_) + 1) * D))[lane + 64 * j] = make_uint2(pkbf(vb_[j].x * rb * gg.x, vb_[j].y * rb * gg.y), pkbf(vb_[j].z * rb * gg.z, vb_[j].w * rb * gg.w)); } } } while (0)
            const int mstep = 2 * NGW;
            float4 wa[4], wb[4];
            for (int m = 2 * gw; m < T; m += 2 * mstep) {
                P0_LOAD(m + mstep, wa, wb);
                P0_ROWS(m, va, vb);
                P0_LOAD(m + 2 * mstep, va, vb);
                P0_ROWS(m + mstep, wa, wb);
            }
#undef P0_LOAD
#undef P0_ROWS
        }
        { float4 v[4]; for (int m = gw; m < 1024; m += NGW) rms_row_bf16(p.mem + (size_t)m * D, p.g_mem, memn + (size_t)m * D, lane, v); }
    }
    xcd_barrier(bar);

    {
        PHASE_IDS
        pg8::Gemm g{hb, WinT, 1024}; pg8::GroupOrder S; S.init(T / 256, 10, 8, G, bid, nullptr, nullptr);
        pg8::EpiBf16Plain E{projb, PW};
        pg8::SideGu SD{p.w_gu, WguT, 0, 80, bid};
        pg8::gemm_phase<pg8::EpiBf16Plain, pg8::GroupOrder, false, false, pg8::SideGu>(L, idxbuf, g, S, E, SD);
        {
            const int fr = lane & 15, g4 = lane >> 4;
            for (int tile = bid * 8 + wave; tile < 2048; tile += G * 8) {
                const int rt = tile >> 5, cp = tile & 31;
                f32x4 c0 = {0.f, 0.f, 0.f, 0.f}, c1 = {0.f, 0.f, 0.f, 0.f};
                const bf16* ap = memn + (size_t)(16 * rt + fr) * 1024 + 8 * g4; const bf16* bp = WkvT + (size_t)(32 * cp + fr) * 1024 + 8 * g4;
#pragma unroll 4
                for (int kc = 0; kc < 32; ++kc) { const bf16x8 a = *(const bf16x8*)(ap + 32 * kc), b0 = *(const bf16x8*)(bp + 32 * kc), b1 = *(const bf16x8*)(bp + 16 * 1024 + 32 * kc);
                    c0 = MFMA16(a, b0, c0); c1 = MFMA16(a, b1, c1); }
#pragma unroll
                for (int nb = 0; nb < 2; ++nb) { const int n = 32 * cp + 16 * nb + fr, isv = n >> 9, hm = (n >> 7) & 3, d = n & 127; bf16* dst = isv ? vmem : kmem;
#pragma unroll
                    for (int i = 0; i < 4; ++i) { const int row = 16 * rt + 4 * g4 + i, b = row >> 8, m = row & 255;
                        dst[((size_t)((b * 4 + hm) * 256 + m)) * 128 + d] = (bf16)f2bf(nb ? c1[i] : c0[i]); } }
            }
        }
    }
    xcd_barrier(bar);

#define WD_CONVERT() do { __syncthreads(); { PHASE_IDS LAS float* xscr = (LAS float*)(L + wave * 17408); const int gw = bid * 8 + wave, NGW = G * 8; \
            constexpr int I_X2 = 16384 + 8192; \
            int it = 16384 + gw; float4 ra[16], rb[16]; \
            XDesc da = xdesc(it < I_X2 ? it : 0, p.w_gu, p.w_down, WguT, WdT), db = da; \
            if (it < I_X2) xload(da, ra, lane); \
            while (it < I_X2) { \
                const int nit = it + NGW; \
                if (nit < I_X2) { db = xdesc(nit, p.w_gu, p.w_down, WguT, WdT); xload(db, rb, lane); } \
                xstore(da, ra, 32.0f, xscr, lane); \
                da = db; \
                _Pragma("unroll") for (int i = 0; i < 16; ++i) ra[i] = rb[i]; \
                it = nit; \
            } } __syncthreads(); } while (0)
    const int wdpos = (bid >> 3) & 3;
    if (wdpos == 0) WD_CONVERT();
    na_attn_phase(L, projb, p.rel_bias, ycr, pss, bid, G);
    if (wdpos == 1) WD_CONVERT();
    mem_attn_phase(L, projb, kmem, vmem, ycr, pss, bid, G);
    if (wdpos == 2) WD_CONVERT();

    ft_stage1_phase(L, projb, Mid, tabC, tabS, tabSn, tab8192, bid, G);
    if (wdpos == 3) WD_CONVERT();
#undef WD_CONVERT
    xcd_barrier(bar);

    ft_stage2_phase(L, Mid, ycr, tab2, pss2, bid, G);
    xcd_barrier(bar);

    {
        PHASE_IDS
        pg8::Gemm g{ycr, WoutT, MIXW}; pg8::GroupOrder S; S.init(T / 256, 4, 8, G, bid, nullptr, nullptr);
        LAS float* rq = (LAS float*)(L + LDS_CTRL + 4096);
        for (int idx = tid; idx < 2 * 256; idx += NTH) {
            const int i = idx >> 8, r = idx & 255; pg8::Unit u;
            if (S.next(i, u)) {
                const size_t row = (size_t)u.pm * 256 + r;
                const float4 a0 = *(const float4*)(pss + row * 12), a1 = *(const float4*)(pss + row * 12 + 4), a2 = *(const float4*)(pss + row * 12 + 8);
                const float s_na = (a0.x + a0.y) + (a0.z + a0.w) + (a1.x + a1.y) + (a1.z + a1.w), s_mem = (a2.x + a2.y) + (a2.z + a2.w), s_ft = pss2[row];
                const float r_na = 1.0f / sqrtf(s_na * (1.0f / 512.0f) + 1e-6f), r_ft = 1.0f / sqrtf(s_ft * (1.0f / 512.0f) + 1e-6f), r_mem = 1.0f / sqrtf(s_mem * (1.0f / 512.0f) + 1e-6f);
                rq[idx * 4 + 0] = r_na / r_ft; rq[idx * 4 + 1] = r_ft / r_mem; rq[idx * 4 + 2] = r_mem;
            }
        }
        __syncthreads();
        pg8::EpiResBf16 E{p.x, x1b, rq};
        pg8::SideGu SD{p.w_gu, WguT, 80, 48, bid};
        pg8::gemm_phase<pg8::EpiResBf16, pg8::GroupOrder, false, false, pg8::SideGu>(L, idxbuf, g, S, E, SD);
    }
    xcd_barrier(bar);

    {
        PHASE_IDS
        const int fr = lane & 15, g4 = lane >> 4;
        constexpr int RW_PITCH = 2064;
        {
            const u32x4_t* sh = (const u32x4_t*)RwH; const u32x4_t* sl = (const u32x4_t*)RwL;
#pragma unroll
            for (int i = 0; i < 8; ++i) { const int pc = tid + 512 * i, row = pc >> 7, ch = pc & 127;
                *(LAS u32x4_t*)(L + row * RW_PITCH + ch * 16) = sh[pc]; *(LAS u32x4_t*)(L + (32 + row) * RW_PITCH + ch * 16) = sl[pc]; }
        }
        LAS unsigned* lcnt = (LAS unsigned*)(L + 64 * RW_PITCH);
        if (tid < 32) lcnt[tid] = 0u;
        __syncthreads();
        for (int tl = bid * 8 + wave; tl < T / 16; tl += G * 8) {
            const int tok = 16 * tl + fr;
            const bf16* xr = x1b + (size_t)tok * D + 8 * g4; unsigned char* hr = h8 + (size_t)tok * D + 8 * g4;
            const float* gp = p.g_ffn + 8 * g4;
            const LAS unsigned char* w0h = L + fr * RW_PITCH + 16 * g4; const LAS unsigned char* w1h = w0h + 16 * RW_PITCH; const LAS unsigned char* w0l = w0h + 32 * RW_PITCH; const LAS unsigned char* w1l = w0h + 48 * RW_PITCH;
            f32x4 acc0 = {0.f, 0.f, 0.f, 0.f}, acc1 = {0.f, 0.f, 0.f, 0.f}; float ssq = 0.f;
#pragma unroll 8
            for (int kc = 0; kc < 32; ++kc) {
                const u32x4_t xw = *(const u32x4_t*)(xr + 32 * kc);
                const float4 a = make_float4(__builtin_bit_cast(float, xw.x << 16), __builtin_bit_cast(float, xw.x & 0xffff0000u), __builtin_bit_cast(float, xw.y << 16), __builtin_bit_cast(float, xw.y & 0xffff0000u));
                const float4 b = make_float4(__builtin_bit_cast(float, xw.z << 16), __builtin_bit_cast(float, xw.z & 0xffff0000u), __builtin_bit_cast(float, xw.w << 16), __builtin_bit_cast(float, xw.w & 0xffff0000u));
                const float4 ga = *(const float4*)(gp + 32 * kc), gb = *(const float4*)(gp + 32 * kc + 4);
                ssq += (a.x * a.x + a.y * a.y) + (a.z * a.z + a.w * a.w) + (b.x * b.x + b.y * b.y) + (b.z * b.z + b.w * b.w);
                const float h0 = a.x * ga.x, h1 = a.y * ga.y, h2v = a.z * ga.z, h3 = a.w * ga.w, h4 = b.x * gb.x, h5 = b.y * gb.y, h6 = b.z * gb.z, h7 = b.w * gb.w;
                u32x4_t hi; hi.x = pkbf(h0, h1); hi.y = pkbf(h2v, h3); hi.z = pkbf(h4, h5); hi.w = pkbf(h6, h7);
                u32x4_t lo;
                lo.x = pkbf(h0 - __builtin_bit_cast(float, hi.x << 16), h1 - __builtin_bit_cast(float, hi.x & 0xffff0000u));
                lo.y = pkbf(h2v - __builtin_bit_cast(float, hi.y << 16), h3 - __builtin_bit_cast(float, hi.y & 0xffff0000u));
                lo.z = pkbf(h4 - __builtin_bit_cast(float, hi.z << 16), h5 - __builtin_bit_cast(float, hi.z & 0xffff0000u));
                lo.w = pkbf(h6 - __builtin_bit_cast(float, hi.w << 16), h7 - __builtin_bit_cast(float, hi.w & 0xffff0000u));
                *(uint2*)(hr + 32 * kc) = make_uint2(pk_fp8x4(h0, h1, h2v, h3), pk_fp8x4(h4, h5, h6, h7));
                const bf16x8 hh = __builtin_bit_cast(bf16x8, hi), hl = __builtin_bit_cast(bf16x8, lo);
                const bf16x8 a0h = *(const LAS bf16x8*)(w0h + 64 * kc), a1h = *(const LAS bf16x8*)(w1h + 64 * kc), a0l = *(const LAS bf16x8*)(w0l + 64 * kc), a1l = *(const LAS bf16x8*)(w1l + 64 * kc);
                acc0 = MFMA16(a0h, hh, acc0); acc0 = MFMA16(a0l, hh, acc0); acc0 = MFMA16(a0h, hl, acc0);
                acc1 = MFMA16(a1h, hh, acc1); acc1 = MFMA16(a1l, hh, acc1); acc1 = MFMA16(a1h, hl, acc1);
            }
            ssq += __shfl_xor(ssq, 16); ssq += __shfl_xor(ssq, 32);
            const float rs = 1.0f / sqrtf(ssq * (1.0f / 1024.0f) + 1e-6f);
            const float4 rb0 = *(const float4*)(p.router_b + 4 * g4), rb1 = *(const float4*)(p.router_b + 16 + 4 * g4);
            float lv[8] = {acc0[0] * rs + rb0.x, acc0[1] * rs + rb0.y, acc0[2] * rs + rb0.z, acc0[3] * rs + rb0.w, acc1[0] * rs + rb1.x, acc1[1] * rs + rb1.y, acc1[2] * rs + rb1.z, acc1[3] * rs + rb1.w};
            float tv[4]; int ti[4];
#pragma unroll
            for (int k = 0; k < 4; ++k) {
                float bv = -3.0e38f; int bi = 0;
#pragma unroll
                for (int j = 0; j < 8; ++j) { const int ej = (j < 4 ? 4 * g4 + j : 16 + 4 * g4 + (j - 4)); if (lv[j] > bv) { bv = lv[j]; bi = ej; } }
#pragma unroll
                for (int o = 16; o <= 32; o <<= 1) { const float ov = __shfl_xor(bv, o); const int oi = __shfl_xor(bi, o); if (ov > bv || (ov == bv && oi < bi)) { bv = ov; bi = oi; } }
                tv[k] = bv; ti[k] = bi;
#pragma unroll
                for (int j = 0; j < 8; ++j) { const int ej = (j < 4 ? 4 * g4 + j : 16 + 4 * g4 + (j - 4)); if (ej == bi) lv[j] = -3.0e38f; }
            }
            const float e1 = expf(tv[1] - tv[0]), e2 = expf(tv[2] - tv[0]), e3 = expf(tv[3] - tv[0]);
            const float inv = 1.0f / (1.0f + e1 + e2 + e3);
            if (g4 == 0) {
                int4 ps;
                ps.x = (int)__hip_atomic_fetch_add(lcnt + ti[0], 1u, __ATOMIC_RELAXED, __HIP_MEMORY_SCOPE_WORKGROUP);
                ps.y = (int)__hip_atomic_fetch_add(lcnt + ti[1], 1u, __ATOMIC_RELAXED, __HIP_MEMORY_SCOPE_WORKGROUP);
                ps.z = (int)__hip_atomic_fetch_add(lcnt + ti[2], 1u, __ATOMIC_RELAXED, __HIP_MEMORY_SCOPE_WORKGROUP);
                ps.w = (int)__hip_atomic_fetch_add(lcnt + ti[3], 1u, __ATOMIC_RELAXED, __HIP_MEMORY_SCOPE_WORKGROUP);
                *(int4*)(tok_e + tok * 4) = make_int4(ti[0], ti[1], ti[2], ti[3]);
                *(float4*)(tok_g + tok * 4) = make_float4(inv, e1 * inv, e2 * inv, e3 * inv);
                *(int4*)(tok_pos + tok * 4) = ps;
                rsbuf[tok] = rs;
            }
        }
        __syncthreads();
        if (tid < 32) bbase[bid * 32 + tid] = atomicAdd(&ctl[CW_CNT + tid * 64], lcnt[tid]);
    }
    xcd_barrier(bar);

    {
        PHASE_IDS
        const int i0 = bid * NTH + tid; int e0 = 0, pos0 = 0; float g0 = 0.f, rs0 = 0.f; unsigned bb0 = 0u;
        if (i0 < T * 4) { e0 = tok_e[i0]; pos0 = tok_pos[i0]; g0 = tok_g[i0]; rs0 = rsbuf[i0 >> 2]; const int p0_ = ((i0 >> 6) >> 3) % G; bb0 = bbase[p0_ * 32 + e0]; }
        if (tid < 64) {
            const int c = lane < 32 ? (int)xb_ld(&ctl[CW_CNT + lane * 64]) : 0, nt_e = (c + 255) >> 8;
            int pre = nt_e;
#pragma unroll
            for (int o = 1; o < 32; o <<= 1) { const int t_ = __shfl_up(pre, o); if (lane >= o) pre += t_; }
            const int start = pre - nt_e;
            if (lane < 32) { scnt[lane] = c; sbase[lane] = start * 256; for (int q = 0; q < nt_e; ++q) tile_e[start + q] = lane; if (lane == 31) sbase[32] = pre * 256; }
        }
        __syncthreads();
        for (int i = bid * NTH + tid; i < MAXSLOT; i += G * NTH) ident[i] = i;
        if (i0 < T * 4) { const int slot = sbase[e0] + (int)bb0 + pos0; slot_tok[slot] = i0 >> 2; slot_gate[slot] = g0; slot_rs[slot] = rs0; tok_slot[i0] = slot; }
        for (int i = i0 + G * NTH; i < T * 4; i += G * NTH) {
            const int e = tok_e[i], blk = ((i >> 6) >> 3) % G, slot = sbase[e] + (int)bbase[blk * 32 + e] + tok_pos[i];
            slot_tok[slot] = i >> 2; slot_gate[slot] = tok_g[i]; slot_rs[slot] = rsbuf[i >> 2]; tok_slot[i] = slot;
        }
        if (bid < 32) { const int e = bid; for (int q = scnt[e] + tid; q < sbase[e + 1] - sbase[e]; q += NTH) { slot_tok[sbase[e] + q] = 0; slot_gate[sbase[e] + q] = 0.f; slot_rs[sbase[e] + q] = 0.f; } }
    }
    xcd_barrier(bar);

    const int ntm = sbase[32] / 256;
    {
        PHASE_IDS
        pg8::Gemm g{(const bf16*)h8, (const bf16*)WguT, 512}; pg8::GroupOrder S; S.init(ntm, 8, 4, G, bid, tile_e, slot_tok);
        pg8::EpiSwiglu E{act, p.b_gu, slot_rs, 1.0f / 32.0f};
        pg8::gemm_phase<pg8::EpiSwiglu, pg8::GroupOrder, true, true>(L, idxbuf, g, S, E);
    }
    xcd_barrier(bar);
    {
        PHASE_IDS
        pg8::Gemm g{(const bf16*)act, (const bf16*)WdT, 512}; pg8::GroupOrder S; S.init(ntm, 4, 8, G, bid, tile_e, ident);
        S.rev = 1;
        pg8::EpiDown E{Yb, p.b_down, slot_gate, 1.0f / 32.0f};
        pg8::gemm_phase<pg8::EpiDown, pg8::GroupOrder, true, true>(L, idxbuf, g, S, E);
    }
    xcd_barrier(bar);

    {
        PHASE_IDS
        const int stride = G * 8, tok0 = bid * 8 + wave;
        float4 gfin[4];
#pragma unroll
        for (int j = 0; j < 4; ++j) gfin[j] = ((const float4*)p.g_final)[lane + 64 * j];
#define P11_CODES(t_) (*(const int4*)(tok_slot + (size_t)((t_) < T ? (t_) : T - 1) * 4))
#define P11_GATES(t_) (*(const float4*)(tok_g + (size_t)((t_) < T ? (t_) : T - 1) * 4))
#define P11_LOAD(t_, c_, xw_, yw_) do { const int _t = (t_) < T ? (t_) : T - 1; const int _sl[4] = {(c_).x, (c_).y, (c_).z, (c_).w}; \
            _Pragma("unroll") for (int j = 0; j < 4; ++j) { { const ntu2 t__ = __builtin_nontemporal_load((const ntu2*)(x1b + (size_t)_t * D) + lane + 64 * j); xw_[j] = make_uint2(t__[0], t__[1]); } \
                _Pragma("unroll") for (int q = 0; q < 4; ++q) yw_[q][j] = __builtin_nontemporal_load((const unsigned*)(Yb + (size_t)_sl[q] * 1024) + lane + 64 * j); } } while (0)
#define P11_COMBINE(t_, xw_, yw_, gq_) do { if ((t_) < T) { float4 v[4]; float s = 0.f; const float gqv_[4] = {(gq_).x * 0.0625f, (gq_).y * 0.0625f, (gq_).z * 0.0625f, (gq_).w * 0.0625f}; \
            _Pragma("unroll") for (int j = 0; j < 4; ++j) { float ax = 0.f, ay = 0.f, az = 0.f, aw = 0.f; \
                _Pragma("unroll") for (int q = 0; q < 4; ++q) { const f32x2_t lo = __builtin_amdgcn_cvt_pk_f32_fp8((int)yw_[q][j], false), hi = __builtin_amdgcn_cvt_pk_f32_fp8((int)yw_[q][j], true); ax = fmaf(lo[0], gqv_[q], ax); ay = fmaf(lo[1], gqv_[q], ay); az = fmaf(hi[0], gqv_[q], az); aw = fmaf(hi[1], gqv_[q], aw); } \
                v[j].x = __builtin_bit_cast(float, xw_[j].x << 16) + ax; v[j].y = __builtin_bit_cast(float, xw_[j].x & 0xffff0000u) + ay; \
                v[j].z = __builtin_bit_cast(float, xw_[j].y << 16) + az; v[j].w = __builtin_bit_cast(float, xw_[j].y & 0xffff0000u) + aw; \
                s += v[j].x * v[j].x + v[j].y * v[j].y + v[j].z * v[j].z + v[j].w * v[j].w; } \
            s = wave_sum(s); const float rs = 1.0f / sqrtf(s * (1.0f / 1024.0f) + 1e-6f); \
            _Pragma("unroll") for (int j = 0; j < 4; ++j) { const float4 gg = gfin[j]; \
                v[j].x *= rs * gg.x; v[j].y *= rs * gg.y; v[j].z *= rs * gg.z; v[j].w *= rs * gg.w; __builtin_nontemporal_store((ntf4){v[j].x, v[j].y, v[j].z, v[j].w}, (ntf4*)(p.out + (size_t)(t_) * D) + lane + 64 * j); } } } while (0)
        if (tok0 < T) {
            int4 cb = P11_CODES(tok0 + stride), ca = P11_CODES(tok0);
            uint2 xa[4], xb[4]; unsigned ya[4][4], yb[4][4]; float4 ga, gb;
            P11_LOAD(tok0, ca, xa, ya); ga = P11_GATES(tok0);
            for (int tok = tok0; tok < T; tok += 2 * stride) {
                ca = P11_CODES(tok + 2 * stride);
                P11_LOAD(tok + stride, cb, xb, yb); gb = P11_GATES(tok + stride);
                P11_COMBINE(tok, xa, ya, ga);
                cb = P11_CODES(tok + 3 * stride);
                P11_LOAD(tok + 2 * stride, ca, xa, ya); ga = P11_GATES(tok + 2 * stride);
                P11_COMBINE(tok + stride, xb, yb, gb);
            }
        }
#undef P11_COMBINE
#undef P11_CODES
#undef P11_LOAD
    }
}

extern "C" void kernel_launch(void* const* d_in, const int* in_sizes, int n_in, void* d_out, int out_size, void* d_ws, size_t ws_size, hipStream_t stream) {
    static int grid = 0;
    if (grid == 0) {
        if (n_in != 17 || in_sizes[0] != T * D || out_size != T * D || ws_size < WS_END) { fprintf(stderr, "kernel_launch: unexpected shapes n_in %d in0 %d out %d ws %zu\n", n_in, n_in > 0 ? in_sizes[0] : -1, out_size, ws_size); grid = -1; return; }
        int dev = 0, cus = 0, per_cu = 0;
        if (hipGetDevice(&dev) != hipSuccess || hipDeviceGetAttribute(&cus, hipDeviceAttributeMultiprocessorCount, dev) != hipSuccess) { grid = -1; return; }
        if (hipFuncSetAttribute((const void*)mk_fwd, hipFuncAttributeMaxDynamicSharedMemorySize, LDS_BYTES) != hipSuccess) { fprintf(stderr, "kernel_launch: hipFuncSetAttribute failed\n"); grid = -1; return; }
        if (hipOccupancyMaxActiveBlocksPerMultiprocessor(&per_cu, (const void*)mk_fwd, NTH, LDS_BYTES) != hipSuccess || per_cu < 1) fprintf(stderr, "kernel_launch: occupancy query says %d\n", per_cu);
        (void)hipGetLastError();
        if (cus != 256) { fprintf(stderr, "kernel_launch: %d CUs (256 expected)\n", cus); grid = -1; return; }
        grid = cus;
    }
    if (grid < 0) return;
    if (hipMemsetAsync((char*)d_ws + WS_CTL, 0, CTL_ZERO_BYTES, stream) != hipSuccess) return;
    Params p{};
    p.x = (const float*)d_in[0]; p.mem = (const float*)d_in[1]; p.g_mix = (const float*)d_in[2]; p.g_mem = (const float*)d_in[3]; p.w_in = (const float*)d_in[4];
    p.w_mem_kv = (const float*)d_in[5]; p.rel_bias = (const float*)d_in[6]; p.g_grp = (const float*)d_in[7]; p.w_out = (const float*)d_in[8]; p.g_ffn = (const float*)d_in[9];
    p.router_w = (const float*)d_in[10]; p.router_b = (const float*)d_in[11]; p.w_gu = (const float*)d_in[12]; p.b_gu = (const float*)d_in[13]; p.w_down = (const float*)d_in[14];
    p.b_down = (const float*)d_in[15]; p.g_final = (const float*)d_in[16]; p.out = (float*)d_out; p.ws = (unsigned char*)d_ws;
    hipLaunchKernelGGL(mk_fwd, dim3(grid), dim3(NTH), LDS_BYTES, stream, p);
}
```
